# Optimizing an MI355X kernel written in HIP

```python
import jax, jax.numpy as jnp
from jax import lax
import numpy as np

D_MODEL = 2048
BATCH = 8
SEQ = 4096
DEPTH = 4
DEC_BATCH = 4
DEC_SEQ = 2048
PAST_LEN = 128

GRID_W = 64
ATT_WIDTH = D_MODEL // 2
RWKV_WIDTH = D_MODEL - ATT_WIDTH
ATT_HEAD_DIM = 128
ATT_HEADS = ATT_WIDTH // ATT_HEAD_DIM
RWKV_HEAD_DIM = 64
RWKV_HEADS = RWKV_WIDTH // RWKV_HEAD_DIM
NA_ROWS = 8
NA_COLS = 16
DECAY_LORA = 64
AAA_LORA = 64
MV_LORA = 32
GATE_LORA = 64
D_FF = 4 * D_MODEL
IN_WIDTH = 3 * ATT_WIDTH + 3 * RWKV_WIDTH
NORM_EPS = 1e-6
GN_EPS = 64e-5

kernel_name = "hymba_natten_rwkv7_bidir_encoder"


def rmsnorm(x, g):
    xf = x.astype(jnp.float32)
    y = xf * lax.rsqrt(jnp.mean(xf * xf, axis=-1, keepdims=True) + NORM_EPS)
    return (y * g.astype(jnp.float32)).astype(x.dtype)


def token_shift(u, mu):
    prev = jnp.pad(u[:, :-1], ((0, 0), (1, 0), (0, 0)))
    nxt = jnp.pad(u[:, 1:], ((0, 0), (0, 1), (0, 0)))
    return u + mu[0] * (prev - u) + mu[1] * (nxt - u)


def neighbourhood_attention(q, k, v, rpb):
    B, T, H, Dh = q.shape
    rows = T // GRID_W
    wr = min(NA_ROWS, rows)
    qg = q.reshape(B, rows, GRID_W, H, Dh)
    kg = k.reshape(B, rows, GRID_W, H, Dh)
    vg = v.reshape(B, rows, GRID_W, H, Dh)
    cols = jnp.arange(GRID_W)
    col_start = jnp.clip(cols - NA_COLS // 2, 0, GRID_W - NA_COLS)
    col_idx = col_start[:, None] + jnp.arange(NA_COLS)[None, :]
    dc = col_idx - cols[:, None]
    scale = ATT_HEAD_DIM ** -0.5

    def row_block(r):
        rs = jnp.clip(r - wr // 2, 0, rows - wr)
        q_r = lax.dynamic_index_in_dim(qg, r, axis=1, keepdims=False)
        k_w = lax.dynamic_slice_in_dim(kg, rs, wr, axis=1)
        v_w = lax.dynamic_slice_in_dim(vg, rs, wr, axis=1)
        k_sel = k_w[:, :, col_idx]
        v_sel = v_w[:, :, col_idx]
        dr = rs + jnp.arange(wr) - r
        bias = rpb[:, (dr + NA_ROWS - 1)[None, :, None], (dc + NA_COLS - 1)[:, None, :]]
        s = jnp.einsum('bqhd,bwqchd->bhqwc', q_r, k_sel).astype(jnp.float32) * scale
        s = s + bias.astype(jnp.float32)[None]
        p = jax.nn.softmax(s.reshape(B, H, GRID_W, wr * NA_COLS), axis=-1)
        p = p.reshape(B, H, GRID_W, wr, NA_COLS).astype(v.dtype)
        return jnp.einsum('bhqwc,bwqchd->bqhd', p, v_sel)

    out = lax.map(row_block, jnp.arange(rows))
    return jnp.moveaxis(out, 0, 1).reshape(B, T, H, Dh)


def wkv_scan(r, w, k, v, a, b, reverse):
    f32 = jnp.float32
    B, T, H, N = r.shape
    xs = tuple(jnp.moveaxis(u.astype(f32), 1, 0) for u in (r, w, k, v, a, b))

    def step(S, inp):
        r_t, w_t, k_t, v_t, a_t, b_t = inp
        sa = jnp.einsum('bhij,bhj->bhi', S, a_t)
        S = S * w_t[:, :, None, :] + sa[..., None] * b_t[:, :, None, :] + v_t[..., None] * k_t[:, :, None, :]
        return S, jnp.einsum('bhij,bhj->bhi', S, r_t)

    S0 = jnp.zeros((B, H, N, N), f32)
    _, y = lax.scan(step, S0, xs, reverse=reverse)
    return jnp.moveaxis(y, 0, 1)


def heads(u):
    return u.reshape(u.shape[:-1] + (RWKV_HEADS, RWKV_HEAD_DIM))


def rwkv_time_mix(h, r, k, v, v_first, mu_rkv, mu_x, w0, w1, w2, a0, a1, a2, g1, g2,
                  k_k, k_a, r_k, ln_w, ln_b, vres):
    f32 = jnp.float32
    B, T, _ = h.shape
    r = token_shift(r, mu_rkv[0])
    k = token_shift(k, mu_rkv[1])
    v = token_shift(v, mu_rkv[2])
    xw = token_shift(h, mu_x[0])
    xa = token_shift(h, mu_x[1])
    xg = token_shift(h, mu_x[2])
    if vres is None:
        v_first = v
    else:
        mu_v, v0, v1, v2 = vres
        xv = token_shift(h, mu_v)
        v = v + (v_first - v) * jax.nn.sigmoid(v0 + (xv @ v1) @ v2)
    w_log = w0[:, None, None, :] + jnp.einsum('ebtr,erc->ebtc', jnp.tanh(jnp.einsum('btd,edr->ebtr', xw, w1)), w2)
    decay = jnp.exp(-jnp.exp(-jax.nn.softplus(-w_log.astype(f32)) - 0.5))
    a = jax.nn.sigmoid(a0[:, None, None, :] + jnp.einsum('ebtr,erc->ebtc', jnp.einsum('btd,edr->ebtr', xa, a1), a2))
    g = jax.nn.sigmoid(xg @ g1) @ g2
    kk = heads((k * k_k).astype(f32))
    kk = kk * lax.rsqrt(jnp.maximum(jnp.sum(kk * kk, axis=-1, keepdims=True), 1e-24))
    k_dir = k[None] * (1.0 + (a - 1.0) * k_a)
    rh = heads(r)
    vh = heads(v)
    y = jnp.zeros((B, T, RWKV_HEADS, RWKV_HEAD_DIM), f32)
    for d, reverse in ((0, False), (1, True)):
        kd = heads(k_dir[d])
        ad = heads(a[d]).astype(f32)
        y = y + wkv_scan(rh, heads(decay[d]), kd, vh, -kk, kk * ad, reverse)
        y = y + (jnp.sum(rh * kd * r_k, axis=-1, keepdims=True) * vh).astype(f32)
    mean = jnp.mean(y, axis=-1, keepdims=True)
    var = jnp.mean(jnp.square(y - mean), axis=-1, keepdims=True)
    y = ((y - mean) * lax.rsqrt(var + GN_EPS)).reshape(B, T, RWKV_WIDTH)
    y = (y * ln_w.astype(f32) + ln_b.astype(f32)).astype(h.dtype)
    return y * g, v_first


def trunk(x, c, w_ada, b_ada, g_pre_mix, g_post_mix, g_pre_ffn, g_post_ffn, w_in, rpb,
          g_att_out, mu_rkv, mu_x, w0, w1, w2, a0, a1, a2, g1, g2, mu_v, v0, v1, v2,
          k_k, k_a, r_k, ln_x_w, ln_x_b, w_out, w_ffn1, w_ffn2):
    B, T, _ = x.shape
    A, R = ATT_WIDTH, RWKV_WIDTH
    cs = jax.nn.silu(c)
    v_first = None
    for l in range(DEPTH):
        mod = (cs @ w_ada[l] + b_ada[l])[:, None, :]
        sh1, sc1, gt1, sh2, sc2, gt2 = jnp.split(mod, 6, axis=-1)
        h = rmsnorm(x, g_pre_mix[l]) * (1.0 + sc1) + sh1
        proj = h @ w_in[l]
        qa, ka, va, rr, kr, vr = jnp.split(proj, [A, 2 * A, 3 * A, 3 * A + R, 3 * A + 2 * R], axis=-1)
        att = neighbourhood_attention(qa.reshape(B, T, ATT_HEADS, ATT_HEAD_DIM),
                                      ka.reshape(B, T, ATT_HEADS, ATT_HEAD_DIM),
                                      va.reshape(B, T, ATT_HEADS, ATT_HEAD_DIM), rpb[l])
        att = rmsnorm(att.reshape(B, T, A), g_att_out[l])
        vres = None if l == 0 else (mu_v[l - 1], v0[l - 1], v1[l - 1], v2[l - 1])
        rw, v_first = rwkv_time_mix(h, rr, kr, vr, v_first, mu_rkv[l], mu_x[l], w0[l], w1[l], w2[l],
                                    a0[l], a1[l], a2[l], g1[l], g2[l], k_k[l], k_a[l], r_k[l],
                                    ln_x_w[l], ln_x_b[l], vres)
        mix = jnp.concatenate([att, rw], axis=-1) @ w_out[l]
        x = x + gt1 * rmsnorm(mix, g_post_mix[l])
        h2 = rmsnorm(x, g_pre_ffn[l]) * (1.0 + sc2) + sh2
        f = jnp.square(jax.nn.relu(h2 @ w_ffn1[l])) @ w_ffn2[l]
        x = x + gt2 * rmsnorm(f, g_post_ffn[l])
    return x


def setup_inputs(seed: int = 0) -> dict:
    key = jax.random.key(seed)
    ks = jax.random.split(key, 40)
    f32 = jnp.float32
    L, D, A, R = DEPTH, D_MODEL, ATT_WIDTH, RWKV_WIDTH

    def nrm(k, shape, scale):
        return jax.random.normal(k, shape, f32) * scale

    def gain(k, shape):
        return 1.0 + 0.02 * jax.random.normal(k, shape, f32)

    def uni(k, shape, lo, hi):
        return jax.random.uniform(k, shape, f32, minval=lo, maxval=hi)

    return {
        "x_prompt": nrm(ks[0], (BATCH, SEQ, D), 1.0),
        "x_sample": nrm(ks[1], (DEC_BATCH, DEC_SEQ, D), 1.0),
        "c_prompt": nrm(ks[2], (BATCH, D), 1.0),
        "c_sample": nrm(ks[3], (DEC_BATCH, D), 1.0),
        "w_ada": nrm(ks[4], (L, D, 6 * D), 0.5 * D ** -0.5),
        "b_ada": nrm(ks[5], (L, 6 * D), 0.02),
        "g_pre_mix": gain(ks[6], (L, D)),
        "g_post_mix": gain(ks[7], (L, D)),
        "g_pre_ffn": gain(ks[8], (L, D)),
        "g_post_ffn": gain(ks[9], (L, D)),
        "w_in": nrm(ks[10], (L, D, IN_WIDTH), D ** -0.5),
        "rpb": nrm(ks[11], (L, ATT_HEADS, 2 * NA_ROWS - 1, 2 * NA_COLS - 1), 0.5),
        "g_att_out": gain(ks[12], (L, A)),
        "mu_rkv": uni(ks[13], (L, 3, 2, R), 0.0, 0.5),
        "mu_x": uni(ks[14], (L, 3, 2, D), 0.0, 0.5),
        "w0": uni(ks[15], (L, 2, R), -5.0, -1.0),
        "w1": nrm(ks[16], (L, 2, D, DECAY_LORA), D ** -0.5),
        "w2": nrm(ks[17], (L, 2, DECAY_LORA, R), 0.3 * DECAY_LORA ** -0.5),
        "a0": nrm(ks[18], (L, 2, R), 0.5),
        "a1": nrm(ks[19], (L, 2, D, AAA_LORA), D ** -0.5),
        "a2": nrm(ks[20], (L, 2, AAA_LORA, R), 0.3 * AAA_LORA ** -0.5),
        "g1": nrm(ks[21], (L, D, GATE_LORA), D ** -0.5),
        "g2": nrm(ks[22], (L, GATE_LORA, R), GATE_LORA ** -0.5),
        "mu_v": uni(ks[23], (L - 1, 2, D), 0.0, 0.5),
        "v0": nrm(ks[24], (L - 1, R), 0.5),
        "v1": nrm(ks[25], (L - 1, D, MV_LORA), D ** -0.5),
        "v2": nrm(ks[26], (L - 1, MV_LORA, R), 0.3 * MV_LORA ** -0.5),
        "k_k": 0.85 + 0.1 * jax.random.normal(ks[27], (L, R), f32),
        "k_a": 1.0 + 0.05 * jax.random.normal(ks[28], (L, R), f32),
        "r_k": nrm(ks[29], (L, RWKV_HEADS, RWKV_HEAD_DIM), 0.1),
        "ln_x_w": gain(ks[30], (L, R)),
        "ln_x_b": nrm(ks[31], (L, R), 0.02),
        "w_out": nrm(ks[32], (L, A + R, D), (A + R) ** -0.5),
        "w_ffn1": nrm(ks[33], (L, D, D_FF), D ** -0.5),
        "w_ffn2": nrm(ks[34], (L, D_FF, D), D_FF ** -0.5),
    }


def reference(x_prompt, x_sample, c_prompt, c_sample, w_ada, b_ada, g_pre_mix, g_post_mix,
              g_pre_ffn, g_post_ffn, w_in, rpb, g_att_out, mu_rkv, mu_x, w0, w1, w2, a0, a1, a2,
              g1, g2, mu_v, v0, v1, v2, k_k, k_a, r_k, ln_x_w, ln_x_b, w_out, w_ffn1, w_ffn2):
    y_prompt = trunk(x_prompt, c_prompt, w_ada, b_ada, g_pre_mix, g_post_mix, g_pre_ffn, g_post_ffn,
                     w_in, rpb, g_att_out, mu_rkv, mu_x, w0, w1, w2, a0, a1, a2, g1, g2, mu_v, v0, v1, v2,
                     k_k, k_a, r_k, ln_x_w, ln_x_b, w_out, w_ffn1, w_ffn2)
    y_sample = trunk(x_sample, c_sample, w_ada, b_ada, g_pre_mix, g_post_mix, g_pre_ffn, g_post_ffn,
                     w_in, rpb, g_att_out, mu_rkv, mu_x, w0, w1, w2, a0, a1, a2, g1, g2, mu_v, v0, v1, v2,
                     k_k, k_a, r_k, ln_x_w, ln_x_b, w_out, w_ffn1, w_ffn2)
    return (y_prompt, y_sample)
```

```cpp
#include <hip/hip_runtime.h>
#include <cstdio>
#include <cstdint>

#ifndef MK_LAUNCH_PER_PHASE
#define MK_LAUNCH_PER_PHASE 0
#define MK_PROBE_REP -1
#define MK_PREP_PROBE 0
#endif
namespace pg8 {
#define PG8_LAS __attribute__((address_space(3)))
typedef unsigned short bf16_t;
typedef short bf16x8 __attribute__((ext_vector_type(8)));
typedef float f32x4 __attribute__((ext_vector_type(4)));
typedef unsigned u32x4 __attribute__((ext_vector_type(4)));
constexpr int BM = 256, BK = 64, HALF = 128, HTB = HALF * BK * 2  , STAGE_BYTES = 8 * HTB, NXCD = 8, WGM = 4;

__host__ __device__ __forceinline__ int lds_byte(int r, int c) { const int st = (r >> 4) * 2 + (c >> 5), rr = r & 15, cc = c & 31, ob = rr * 64 + cc * 2; return st * 1024 + (ob ^ (((ob >> 9) & 1) << 5)); }
__host__ __device__ __forceinline__ void stage_rc(int b, int& R, int& C) { const int st = b / 1024, sb = b % 1024, swz = sb ^ (((sb >> 9) & 1) << 5); R = (st >> 1) * 16 + swz / 64; C = (st & 1) * 32 + (swz % 64) / 2; }
__host__ __device__ __forceinline__ int perm32(int rho) { const int n = rho >> 4, i = rho & 15; return 8 * (i >> 2) + 4 * n + (i & 3); }

struct Unit { int pm, pn; };
struct Gemm { const bf16_t* A; const bf16_t* Bt; int M, N, K; };

struct StaticOrder {
    int nM, nN, nwg, G, c;
    __host__ __device__ void init(int M, int N, int G_, int c_) { nM = M / BM; nN = N / BM; nwg = nM * nN; G = G_; c = c_; }
    __host__ __device__ bool next(int i, Unit& u) const {
        const long L = (long)i * G + c; if (L >= nwg) return false;
        int wgid = (int)L; { const int q = nwg / NXCD, r = nwg % NXCD, xcd = wgid % NXCD, off = wgid / NXCD; wgid = (xcd < r ? xcd * (q + 1) : r * (q + 1) + (xcd - r) * q) + off; }
        const int nig = WGM * nN, gid = wgid / nig, fm = gid * WGM, gsz = (nM - fm) < WGM ? (nM - fm) : WGM;
        u.pm = fm + ((wgid % nig) % gsz); u.pn = (wgid % nig) / gsz; return true;
    }
    __device__ __forceinline__ void a_ready(const Unit&) const {}
    __device__ __forceinline__ void done(const Unit&) const {}
};
__device__ __forceinline__ unsigned cvt_pk_bf16(float lo, float hi) { unsigned r; asm volatile("v_cvt_pk_bf16_f32 %0, %1, %2" : "=v"(r) : "v"(lo), "v"(hi)); return r; }
template <int ACT> struct EpiOut {
    static constexpr bool PERM = true, AFTER_DRAIN = false;
    bf16_t* O0; int ld0; bf16_t* O1; int ld1; int split_tile; bf16_t* CG; int cg_tiles; int cg_rows;
    __device__ __forceinline__ void operator()(const f32x4 (&acc)[2][2][4][2], const Unit& u, int wr, int wc, int fr, int fq) const {
        const int row0 = u.pm * BM + wr * 64 + fr;
        bf16_t* base; size_t rstride, bjstep;
        if (u.pn < split_tile) { base = O0 + (size_t)u.pn * BM + wc * 32 + 8 * fq; rstride = (size_t)ld0; bjstep = HALF; }
        else if (u.pn < split_tile + cg_tiles) { base = CG + (size_t)((u.pn - split_tile) * 8 + wc) * cg_rows * 32 + 8 * fq; rstride = 32; bjstep = (size_t)4 * cg_rows * 32; }
        else { base = O1 + (size_t)(u.pn - split_tile - cg_tiles) * BM + wc * 32 + 8 * fq; rstride = (size_t)ld1; bjstep = HALF; }
#pragma unroll
        for (int ai = 0; ai < 2; ++ai)
#pragma unroll
            for (int m = 0; m < 4; ++m) { bf16_t* rowp = base + (size_t)(row0 + ai * HALF + m * 16) * rstride;
#pragma unroll
                for (int bj = 0; bj < 2; ++bj) { f32x4 v0 = acc[ai][bj][m][0], v1 = acc[ai][bj][m][1];
                    if (ACT == 1) {
#pragma unroll
                        for (int j = 0; j < 4; ++j) { const float a = v0[j] > 0.f ? v0[j] : 0.f, b = v1[j] > 0.f ? v1[j] : 0.f; v0[j] = a * a; v1[j] = b * b; } }
                    u32x4 w; w.x = cvt_pk_bf16(v0[0], v0[1]); w.y = cvt_pk_bf16(v0[2], v0[3]); w.z = cvt_pk_bf16(v1[0], v1[1]); w.w = cvt_pk_bf16(v1[2], v1[3]);
                    if (ACT == 1) __builtin_nontemporal_store(w, (u32x4*)(rowp + bj * bjstep)); else *(u32x4*)(rowp + bj * bjstep) = w;
#if defined(MK_PREP_PROBE) && MK_PREP_PROBE == 6
                    if (ACT == 1) { asm volatile("" ::: "memory"); *(u32x4*)(rowp + bj * bjstep) = w; }
#endif
                    } }
    }
};

template <class Epi, class Sched, bool ALIGN_EPI = false, bool SP2 = false>
__device__ __forceinline__ void gemm_phase(PG8_LAS unsigned char* lds, const Gemm g, const Sched& S, const Epi& E, const int tid) {
    const int wid = __builtin_amdgcn_readfirstlane(tid >> 6), lane = tid & 63, wr = wid >> 2, wc = wid & 3, fr = lane & 15, fq = lane >> 4;
    const int K = g.K, nt = K / BK;
    unsigned voffA[2], voffB[2];
#pragma unroll
    for (int i = 0; i < 2; ++i) { int R, C; stage_rc(tid * 16 + i * 8192, R, C); const int Rb = Epi::PERM ? ((R & ~31) + perm32(R & 31)) : R;
        voffA[i] = (unsigned)(R * K + C) * 2u; voffB[i] = (unsigned)(Rb * K + C) * 2u; }
    const size_t kstep = (size_t)(BK * 2);
    const size_t hstep = (size_t)HALF * K * 2;
    const size_t tstep = 2 * hstep;
    const unsigned ldsw = (unsigned)wid * 1024u;
    const int aoff = lds_byte(wr * 64 + fr, fq * 8), boff = lds_byte(wc * 32 + fr, fq * 8);
#define PG8_SA(b, h) (((b) * 2 + (h)) * HTB)
#define PG8_SB(b, h) ((4 + (b) * 2 + (h)) * HTB)
#define PG8_STAGE(bufoff, gbase, voff) do { _Pragma("unroll") for (int _i = 0; _i < 2; ++_i) \
        __builtin_amdgcn_global_load_lds((const unsigned*)((const char*)(gbase) + (voff)[_i]), (PG8_LAS unsigned*)(lds + (bufoff) + ldsw + _i * 8192), 16, 0, 0); } while (0)
#define PG8_LDA(dst, b, h) do { _Pragma("unroll") for (int m = 0; m < 4; ++m) _Pragma("unroll") for (int k = 0; k < 2; ++k) dst[m][k] = *(const PG8_LAS bf16x8*)(lds + PG8_SA(b, h) + aoff + m * 2048 + k * 1024); } while (0)
#define PG8_LDB(dst, b, h) do { _Pragma("unroll") for (int n = 0; n < 2; ++n) _Pragma("unroll") for (int k = 0; k < 2; ++k) dst[n][k] = *(const PG8_LAS bf16x8*)(lds + PG8_SB(b, h) + boff + n * 2048 + k * 1024); } while (0)
#define PG8_MMA(ai, bj, At, Bt) do { __builtin_amdgcn_s_setprio(1); _Pragma("unroll") for (int m = 0; m < 4; ++m) _Pragma("unroll") for (int n = 0; n < 2; ++n) _Pragma("unroll") for (int k = 0; k < 2; ++k) \
        acc[ai][bj][m][n] = __builtin_amdgcn_mfma_f32_16x16x32_bf16(Bt[n][k], At[m][k], acc[ai][bj][m][n], 0, 0, 0); __builtin_amdgcn_s_setprio(0); } while (0)
#define PG8_WAIT_V(n) asm volatile("s_waitcnt vmcnt(" #n ")" ::: "memory")
#define PG8_WAIT_L(n) asm volatile("s_waitcnt lgkmcnt(" #n ")" ::: "memory")
#define PG8_BAR __builtin_amdgcn_s_barrier()
#define PG8_SCHED __builtin_amdgcn_sched_barrier(0)
    Unit cur, nxt; int ui = 0;
    if (!S.next(0, cur)) return;
    f32x4 acc[2][2][4][2];
#pragma unroll
    for (int a = 0; a < 2; ++a)
#pragma unroll
        for (int b = 0; b < 2; ++b)
#pragma unroll
            for (int m = 0; m < 4; ++m)
#pragma unroll
                for (int n = 0; n < 2; ++n) acc[a][b][m][n] = (f32x4){0.f, 0.f, 0.f, 0.f};
    bf16x8 At[4][2], B0[2][2], B1[2][2];
    const char* cA = (const char*)g.A + (size_t)cur.pm * tstep; const char* cB = (const char*)g.Bt + (size_t)cur.pn * tstep;
    S.a_ready(cur);
    if constexpr (SP2) {
        PG8_STAGE(PG8_SB(0, 0), cB, voffB); PG8_STAGE(PG8_SB(0, 1), cB + hstep, voffB); PG8_STAGE(PG8_SA(0, 0), cA, voffA); PG8_STAGE(PG8_SA(0, 1), cA + hstep, voffA);
        if (wr == 1) PG8_BAR;
        PG8_WAIT_V(2); PG8_BAR;
        PG8_STAGE(PG8_SB(1, 0), cB + kstep, voffB); PG8_STAGE(PG8_SA(1, 0), cA + kstep, voffA); PG8_STAGE(PG8_SB(1, 1), cB + hstep + kstep, voffB);
        PG8_WAIT_V(6); PG8_BAR;
    } else {
        PG8_STAGE(PG8_SB(0, 0), cB, voffB); PG8_STAGE(PG8_SA(0, 0), cA, voffA); PG8_STAGE(PG8_SB(0, 1), cB + hstep, voffB); PG8_STAGE(PG8_SA(0, 1), cA + hstep, voffA);
        if (wr == 1) PG8_BAR;
        PG8_WAIT_V(4); PG8_BAR;
        PG8_STAGE(PG8_SB(1, 0), cB + kstep, voffB); PG8_STAGE(PG8_SA(1, 0), cA + kstep, voffA); PG8_STAGE(PG8_SB(1, 1), cB + hstep + kstep, voffB);
        PG8_WAIT_V(6); PG8_BAR;
    }
    for (;;) {
        const bool has_next = S.next(ui + 1, nxt);
        const char* nA = has_next ? (const char*)g.A + (size_t)nxt.pm * tstep : cA; const char* nB = has_next ? (const char*)g.Bt + (size_t)nxt.pn * tstep : cB;
        for (int t = 0; t < nt; t += 2) {
            const bool last = (t == nt - 2);
            const char* a1 = cA + (size_t)(t + 1) * kstep;
            const char* a2 = last ? nA : cA + (size_t)(t + 2) * kstep; const char* b2 = last ? nB : cB + (size_t)(t + 2) * kstep;
            const char* a3 = a2 + kstep; const char* b3 = b2 + kstep;
            if (last && has_next) S.a_ready(nxt);
            if constexpr (SP2) {
            PG8_LDB(B0, 0, 0); PG8_LDB(B1, 0, 1); PG8_SCHED; PG8_LDA(At, 0, 0); PG8_STAGE(PG8_SA(1, 1), a1 + hstep, voffA);
            PG8_WAIT_V(8); PG8_WAIT_L(0); PG8_BAR; PG8_MMA(0, 0, At, B0); PG8_MMA(0, 1, At, B1); PG8_BAR; PG8_SCHED;
            PG8_LDA(At, 0, 1); PG8_STAGE(PG8_SB(0, 0), b2, voffB); PG8_STAGE(PG8_SB(0, 1), b2 + hstep, voffB); PG8_STAGE(PG8_SA(0, 0), a2, voffA);
            PG8_WAIT_V(8); PG8_WAIT_L(0); PG8_BAR; PG8_MMA(1, 0, At, B0); PG8_MMA(1, 1, At, B1); PG8_BAR; PG8_SCHED;
            PG8_LDB(B0, 1, 0); PG8_LDB(B1, 1, 1); PG8_SCHED; PG8_LDA(At, 1, 0); PG8_STAGE(PG8_SA(0, 1), a2 + hstep, voffA);
            PG8_WAIT_V(8); PG8_WAIT_L(0); PG8_BAR; PG8_MMA(0, 0, At, B0); PG8_MMA(0, 1, At, B1); PG8_BAR; PG8_SCHED;
            PG8_LDA(At, 1, 1); PG8_STAGE(PG8_SB(1, 0), b3, voffB); PG8_STAGE(PG8_SB(1, 1), b3 + hstep, voffB); PG8_STAGE(PG8_SA(1, 0), a3, voffA);
            PG8_WAIT_V(8); PG8_WAIT_L(0); PG8_BAR; PG8_MMA(1, 0, At, B0); PG8_MMA(1, 1, At, B1); PG8_BAR; PG8_SCHED;
            } else {
            PG8_LDB(B0, 0, 0); PG8_SCHED; PG8_LDA(At, 0, 0); PG8_STAGE(PG8_SA(1, 1), a1 + hstep, voffA);
            PG8_WAIT_L(8); PG8_BAR; PG8_WAIT_L(0); PG8_MMA(0, 0, At, B0); PG8_BAR; PG8_SCHED;
            PG8_LDB(B1, 0, 1); PG8_STAGE(PG8_SB(0, 0), b2, voffB);
            PG8_BAR; PG8_WAIT_L(0); PG8_MMA(0, 1, At, B1); PG8_BAR;
            PG8_LDA(At, 0, 1); PG8_STAGE(PG8_SA(0, 0), a2, voffA);
            PG8_BAR; PG8_WAIT_L(0); PG8_MMA(1, 0, At, B0); PG8_BAR; PG8_SCHED;
            PG8_STAGE(PG8_SB(0, 1), b2 + hstep, voffB);
            PG8_WAIT_V(6); PG8_BAR; PG8_MMA(1, 1, At, B1); PG8_BAR;
            PG8_LDB(B0, 1, 0); PG8_SCHED; PG8_LDA(At, 1, 0); PG8_STAGE(PG8_SA(0, 1), a2 + hstep, voffA);
            PG8_WAIT_L(8); PG8_BAR; PG8_WAIT_L(0); PG8_MMA(0, 0, At, B0); PG8_BAR; PG8_SCHED;
            PG8_LDB(B1, 1, 1); PG8_STAGE(PG8_SB(1, 0), b3, voffB);
            PG8_BAR; PG8_WAIT_L(0); PG8_MMA(0, 1, At, B1); PG8_BAR;
            PG8_LDA(At, 1, 1); PG8_STAGE(PG8_SA(1, 0), a3, voffA);
            PG8_BAR; PG8_WAIT_L(0); PG8_MMA(1, 0, At, B0); PG8_BAR; PG8_SCHED;
            PG8_STAGE(PG8_SB(1, 1), b3 + hstep, voffB);
            PG8_WAIT_V(6); PG8_BAR; PG8_MMA(1, 1, At, B1); PG8_BAR;
            }
        }
        if constexpr (ALIGN_EPI) { if (wr == 0) PG8_BAR; }
        if constexpr (!Epi::AFTER_DRAIN) { E(acc, cur, wr, wc, fr, fq); S.done(cur); }
        if (!has_next) break;
#pragma unroll
        for (int a = 0; a < 2; ++a)
#pragma unroll
            for (int b = 0; b < 2; ++b)
#pragma unroll
                for (int m = 0; m < 4; ++m)
#pragma unroll
                    for (int n = 0; n < 2; ++n) acc[a][b][m][n] = (f32x4){0.f, 0.f, 0.f, 0.f};
        cur = nxt; cA = nA; cB = nB; ++ui;
        if constexpr (ALIGN_EPI) { if (wr == 1) PG8_BAR; }
    }
    PG8_WAIT_V(0);
    if constexpr (!ALIGN_EPI) { if (wr == 0) PG8_BAR; }
    PG8_BAR;
    if constexpr (Epi::AFTER_DRAIN) { E.fused(acc, cur, wr, wc, fr, fq, lds, wid, lane); S.done(cur); }
#undef PG8_SA
#undef PG8_SB
#undef PG8_STAGE
#undef PG8_LDA
#undef PG8_LDB
#undef PG8_MMA
#undef PG8_WAIT_V
#undef PG8_WAIT_L
#undef PG8_BAR
#undef PG8_SCHED
}
}
#define XB_TMO      128
#define XB_XCNT(j)  (256  + 64 * (j))
#define XB_XSUB(j)  (1280 + 64 * (j))
#define XB_XGEN(j)  (2304 + 64 * (j))
#define XB_TOP      3328
#define XB_TOPGEN   3392
#define XCD_BAR_WORDS 3456
#define XB_SPIN_CAP (1u << 18)
#define LAS __attribute__((address_space(3)))

__device__ __forceinline__ unsigned xb_ld(unsigned* p)              { return __hip_atomic_load(p, __ATOMIC_RELAXED, __HIP_MEMORY_SCOPE_AGENT); }
__device__ __forceinline__ unsigned xb_add(unsigned* p, unsigned v) { return __hip_atomic_fetch_add(p, v, __ATOMIC_RELAXED, __HIP_MEMORY_SCOPE_AGENT); }
__device__ __forceinline__ unsigned xb_xcc_id() { return (unsigned)__builtin_amdgcn_s_getreg((3 << 11) | 20) & 0xFu; }
#define XB_SPIN(cond, bar) do { unsigned _sp = 0; while (cond) { __builtin_amdgcn_s_sleep(1); \
    if ((++_sp & 255u) == 0u) { if (xb_ld(&(bar)[XB_TMO])) break; if (_sp > XB_SPIN_CAP) { atomicAdd(&(bar)[XB_TMO], 1u); break; } } } } while (0)

struct XcdBarrier {
    unsigned* bar; unsigned x;
    volatile LAS unsigned* st;
};

__device__ __forceinline__ XcdBarrier xcd_barrier_post(unsigned* bar, volatile LAS unsigned* st) {
    XcdBarrier b; b.bar = bar; b.x = xb_xcc_id(); b.st = st;
    if (threadIdx.x == 0) (void)xb_add(&bar[XB_XCNT(b.x)], 1u);
    return b;
}
__device__ __forceinline__ void xcd_barrier_complete(unsigned* bar, unsigned x, unsigned& nloc, unsigned& nx) {
    const unsigned G = gridDim.x * gridDim.y * gridDim.z;
    unsigned sum, cnt, mine, sp = 0u;
    for (;;) {
        sum = 0u; cnt = 0u; mine = 0u;
#pragma unroll
        for (unsigned j = 0; j < 16; ++j) { const unsigned c = xb_ld(&bar[XB_XCNT(j)]); sum += c; cnt += (c > 0u) ? 1u : 0u; mine = (j == x) ? c : mine; }
        if (sum == G) break;
        __builtin_amdgcn_s_sleep(1);
        if ((++sp & 255u) == 0u) { if (xb_ld(&bar[XB_TMO])) break; if (sp > XB_SPIN_CAP) { atomicAdd(&bar[XB_TMO], 1u); break; } }
    }
    nloc = mine > 0u ? mine : 1u; nx = cnt > 0u ? cnt : 1u;
}

__device__ __forceinline__ void xcd_barrier(const XcdBarrier& b) {
    asm volatile("s_waitcnt vmcnt(0)" ::: "memory");
    __syncthreads();
    if (threadIdx.x == 0) {
        unsigned* bar = b.bar;
        __builtin_amdgcn_s_waitcnt(0);
        unsigned nloc = b.st[0], nx = b.st[1];
        if (nloc == 0u) { xcd_barrier_complete(bar, b.x, nloc, nx); b.st[0] = nloc; b.st[1] = nx; }
        const unsigned old = xb_add(&bar[XB_XSUB(b.x)], 1u);
        const unsigned gen = old / nloc;
        if (old + 1u == (gen + 1u) * nloc) {
            __builtin_amdgcn_fence(__ATOMIC_RELEASE, "agent");
            asm volatile("s_waitcnt vmcnt(0)" ::: "memory");
            const unsigned og = xb_add(&bar[XB_TOP], 1u);
            const unsigned tg = og / nx;
            if (og + 1u == (tg + 1u) * nx) xb_add(&bar[XB_TOPGEN], 1u);
            else XB_SPIN(xb_ld(&bar[XB_TOPGEN]) == tg, bar);
            __builtin_amdgcn_fence(__ATOMIC_ACQUIRE, "agent");
            xb_add(&bar[XB_XGEN(b.x)], 1u);
            asm volatile("s_waitcnt vmcnt(0)" ::: "memory");
        } else {
            XB_SPIN(xb_ld(&bar[XB_XGEN(b.x)]) == gen, bar);
            __builtin_amdgcn_fence(__ATOMIC_ACQUIRE, "agent");
            asm volatile("s_waitcnt vmcnt(0)" ::: "memory");
        }
    }
    __syncthreads();
}
constexpr int D = 2048, DEPTH = 4, NSEQ = 12, TOK = 40960, TP = 32768;
constexpr int NAH = 8, NRH = 16, DFF = 8192;
constexpr int LORA = 352;
constexpr int NPROJ = 6144, NIN = 7424;
constexpr int NQKV = 3072, NLB = 1280;
constexpr int NT64 = TOK / 64;
constexpr float NORM_EPS = 1e-6f, GN_EPS = 64e-5f;

constexpr size_t MiB = 1u << 20;
constexpr size_t WS_CTL = 0, CTL_ZERO_BYTES = 1 * MiB;
constexpr size_t WS_MOD = 1 * MiB;
constexpr size_t WS_LUP = 4 * MiB;
constexpr size_t WS_WIN = 8 * MiB;
constexpr size_t WS_WOUT = 66 * MiB;
constexpr size_t WS_XB = 82 * MiB;
constexpr size_t WS_WF1 = 242 * MiB;
constexpr size_t WS_WF2 = 274 * MiB;
constexpr size_t WS_VFIRST = 306 * MiB;
constexpr size_t WS_HB = 386 * MiB;
constexpr size_t WS_EX = 546 * MiB;
constexpr size_t WS_QKV = 706 * MiB;
constexpr size_t WS_RBUF = 946 * MiB;
constexpr size_t WS_LORA = 1186 * MiB;
constexpr size_t WS_MIXIN = 1286 * MiB;
constexpr size_t WS_KN = 1446 * MiB;
constexpr size_t WS_SSQ = 1454 * MiB;
constexpr size_t WS_G = 1456 * MiB;
constexpr size_t WS_END = 1536 * MiB;
constexpr size_t WS_HID = WS_QKV;
constexpr size_t PLANE = (size_t)TOK * 1024;
constexpr int LUP_W2 = 0, LUP_A2 = 131072, LUP_G2 = 262144, LUP_V2 = 327680, LUP_LAYER = 360448;
constexpr int CW_BAR = 4096;

constexpr int LDS_BYTES = 163840;
constexpr int L_RING = 0;
constexpr int L_BIAS = 131072;
constexpr int L_EXCH = 147456;
constexpr int L_MISC = 163584;
constexpr int L_TRS = 8448;
constexpr int L_PRM = 69632;

#define DI __device__ __forceinline__
typedef unsigned short bf16;
typedef unsigned u32x4 __attribute__((ext_vector_type(4)));
typedef unsigned u32x2 __attribute__((ext_vector_type(2)));
typedef float f32x4 __attribute__((ext_vector_type(4)));
typedef float f32x2 __attribute__((ext_vector_type(2)));
typedef float f32x16 __attribute__((ext_vector_type(16)));
typedef short bf16x8 __attribute__((ext_vector_type(8)));
typedef short s16x4 __attribute__((ext_vector_type(4)));
typedef _Float16 f16x2 __attribute__((ext_vector_type(2)));

DI float bflo(unsigned w) { return __uint_as_float(w << 16); }
DI float bfhi(unsigned w) { return __uint_as_float(w & 0xffff0000u); }
DI unsigned f2bf(float f) { unsigned u = __float_as_uint(f); return (u + 0x7fffu + ((u >> 16) & 1u)) >> 16; }
typedef __bf16 bf16v2_t __attribute__((ext_vector_type(2)));
DI unsigned pkbf(float lo, float hi) { return __builtin_bit_cast(unsigned, __builtin_convertvector((f32x2){lo, hi}, bf16v2_t)); }
DI unsigned pk2(float lo, float hi) { return pkbf(lo, hi); }
DI unsigned pkh2(float lo, float hi) { f16x2 v; v.x = (_Float16)lo; v.y = (_Float16)hi; return __builtin_bit_cast(unsigned, v); }
DI float hlo(unsigned w) { return (float)__builtin_bit_cast(f16x2, w).x; }
DI float hhi(unsigned w) { return (float)__builtin_bit_cast(f16x2, w).y; }
DI float h2f(unsigned short h) { return (float)__builtin_bit_cast(_Float16, h); }
DI unsigned short f2h(float f) { return __builtin_bit_cast(unsigned short, (_Float16)f); }
DI float wave_sum(float v) {
#pragma unroll
    for (int o = 1; o < 64; o <<= 1) v += __shfl_xor(v, o);
    return v;
}
#define DPP_ROR_ADD(v, n) ((v) + __builtin_bit_cast(float, __builtin_amdgcn_update_dpp(0, __builtin_bit_cast(int, (v)), 0x120 + (n), 0xf, 0xf, false)))
DI float wave_sum_dpp(float v) {
    v = DPP_ROR_ADD(v, 8); v = DPP_ROR_ADD(v, 4); v = DPP_ROR_ADD(v, 2); v = DPP_ROR_ADD(v, 1);
    const int b = __builtin_bit_cast(int, v);
    return (__builtin_bit_cast(float, __builtin_amdgcn_readlane(b, 0)) + __builtin_bit_cast(float, __builtin_amdgcn_readlane(b, 16))) +
           (__builtin_bit_cast(float, __builtin_amdgcn_readlane(b, 32)) + __builtin_bit_cast(float, __builtin_amdgcn_readlane(b, 48)));
}
DI float sigmoidf_(float x) { return __builtin_amdgcn_rcpf(1.0f + __expf(-x)); }
DI float tanhf_(float x) { const float e = __expf(2.0f * x); return 1.0f - 2.0f * __builtin_amdgcn_rcpf(1.0f + e); }
DI int seq_start(int s) { return s < 8 ? s * 4096 : TP + (s - 8) * 2048; }
DI int seq_len(int s) { return s < 8 ? 4096 : 2048; }
DI void tokinfo(int m, int& s, int& t, int& T) { if (m < TP) { s = m >> 12; t = m & 4095; T = 4096; } else { const int mm = m - TP; s = 8 + (mm >> 11); t = mm & 2047; T = 2048; } }

struct Args { const float* in[35]; float* out; unsigned char* ws; int ph_lo, ph_hi; };
typedef const __attribute__((address_space(4))) Args CArgs;
enum { I_XP = 0, I_XS, I_CP, I_CS, I_WADA, I_BADA, I_GPREMIX, I_GPOSTMIX, I_GPREFFN, I_GPOSTFFN, I_WIN, I_RPB, I_GATT, I_MURKV, I_MUX, I_W0, I_W1, I_W2, I_A0, I_A1, I_A2,
       I_G1, I_G2, I_MUV, I_V0, I_V1, I_V2, I_KK, I_KA, I_RK, I_LNW, I_LNB, I_WOUT, I_WF1, I_WF2 };
DI const float* mod_ptr(CArgs& a, int l, int s, int k) { return (const float*)(a.ws + WS_MOD) + ((size_t)(l * NSEQ + s) * 6 + k) * D; }
template <int KB>
DI void transpose_item(const float* W, int K, int N, bf16* WT, int row_off, LAS float* scr, int item, int lane, const float* mu, int variant) {
    const int nblk = N / 32, kb = item / nblk, nb = item % nblk, k0 = KB * kb, n0 = 32 * nb;
#pragma unroll 8
    for (int i = 0; i < KB / 2; ++i) { const int kk = 2 * i + (lane >> 5); float v = W ? W[(size_t)(k0 + kk) * N + n0 + (lane & 31)] : 0.f;
        if (mu) { const float m0 = mu[k0 + kk], m1 = mu[K + k0 + kk]; v *= (variant == 0) ? (1.0f - m0 - m1) : (variant == 1 ? m0 : m1); }
        scr[kk * 33 + (lane & 31)] = v; }
    asm volatile("s_waitcnt lgkmcnt(0)" ::: "memory");
    constexpr int CH = KB / 8, RPP = 64 / CH;
    const int c = lane % CH;
#pragma unroll
    for (int j = 0; j < 32 / RPP; ++j) { const int n = lane / CH + RPP * j; const LAS float* s = scr + (8 * c) * 33 + n;
        u32x4 o; o.x = pk2(s[0 * 33], s[1 * 33]); o.y = pk2(s[2 * 33], s[3 * 33]); o.z = pk2(s[4 * 33], s[5 * 33]); o.w = pk2(s[6 * 33], s[7 * 33]);
        *(u32x4*)(WT + (size_t)(row_off + n0 + n) * K + k0 + 8 * c) = o; }
    asm volatile("s_waitcnt lgkmcnt(0)" ::: "memory");
}
template <int KB> DI void ffn_weight_item(CArgs& a, int l, int it, LAS float* scr, int lane) {
    constexpr int S = 64 / KB;
    if (it < 8192 * S) transpose_item<KB>(a.in[I_WF1] + (size_t)l * D * DFF, D, DFF, (bf16*)(a.ws + WS_WF1), 0, scr, it, lane, nullptr, 0);
    else transpose_item<KB>(a.in[I_WF2] + (size_t)l * DFF * D, DFF, D, (bf16*)(a.ws + WS_WF2), 0, scr, it - 8192 * S, lane, nullptr, 0);
}
constexpr int IT_WIN = 6144, IT_LORA = 1056, IT_WOUT = 2048, IT_LAYER = IT_WIN + IT_LORA + IT_WOUT;
template <int KB> DI void layer_weight_item(CArgs& a, int l, int r, LAS float* scr, int lane) {
    constexpr int S = 64 / KB;
    bf16* wint = (bf16*)(a.ws + WS_WIN) + (size_t)(l & 1) * NIN * D;
    if (r < IT_WIN * S) { transpose_item<KB>(a.in[I_WIN] + (size_t)l * D * NPROJ, D, NPROJ, wint, 0, scr, r, lane, nullptr, 0); return; }
    r -= IT_WIN * S;
    if (r < IT_LORA * S) {
        if (r < 960 * S) { const int mat = r / (192 * S), variant = (r % (192 * S)) / (64 * S), item = r % (64 * S);
            const float* W; const float* mu;
            if (mat < 2) { W = a.in[I_W1] + (size_t)(l * 2 + mat) * D * 64; mu = a.in[I_MUX] + (size_t)(l * 3 + 0) * 2 * D; }
            else if (mat < 4) { W = a.in[I_A1] + (size_t)(l * 2 + (mat - 2)) * D * 64; mu = a.in[I_MUX] + (size_t)(l * 3 + 1) * 2 * D; }
            else { W = a.in[I_G1] + (size_t)l * D * 64; mu = a.in[I_MUX] + (size_t)(l * 3 + 2) * 2 * D; }
            transpose_item<KB>(W, D, 64, wint, NPROJ + variant * LORA + 64 * mat, scr, item, lane, mu, variant);
        } else { const int jj = r - 960 * S, variant = jj / (32 * S), item = jj % (32 * S);
            const float* W = l > 0 ? a.in[I_V1] + (size_t)(l - 1) * D * 32 : nullptr; const float* mu = l > 0 ? a.in[I_MUV] + (size_t)(l - 1) * 2 * D : nullptr;
            transpose_item<KB>(W, D, 32, wint, NPROJ + variant * LORA + 320, scr, item, lane, mu, variant); }
        return; }
    r -= IT_LORA * S;
    transpose_item<KB>(a.in[I_WOUT] + (size_t)l * D * D, D, D, (bf16*)(a.ws + WS_WOUT) + (size_t)(l & 1) * D * D, 0, scr, r, lane, nullptr, 0);
}
constexpr int BG_FFN = 16384 * 2, BG_LAYER = IT_LAYER * 2;
DI void bg_decode(CArgs& a, int l, int it, const float*& W, const float*& mu, bf16*& WT, int& K, int& N, int& row_off, int& item, int& variant) {
    mu = nullptr; variant = 0; row_off = 0;
    if (it < BG_FFN) {
        if (it < 16384) { W = a.in[I_WF1] + (size_t)l * D * DFF; K = D; N = DFF; WT = (bf16*)(a.ws + WS_WF1); item = it; }
        else { W = a.in[I_WF2] + (size_t)l * DFF * D; K = DFF; N = D; WT = (bf16*)(a.ws + WS_WF2); item = it - 16384; }
        return; }
    const int ln = l + 1; int r = it - BG_FFN;
    bf16* wint = (bf16*)(a.ws + WS_WIN) + (size_t)(ln & 1) * NIN * D;
    if (r < 2 * IT_WIN) { W = a.in[I_WIN] + (size_t)ln * D * NPROJ; K = D; N = NPROJ; WT = wint; item = r; return; }
    r -= 2 * IT_WIN;
    if (r < 2 * IT_LORA) { K = D; WT = wint;
        if (r < 1920) { const int mat = r / 384; variant = (r % 384) / 128; item = r % 128; N = 64;
            if (mat < 2) { W = a.in[I_W1] + (size_t)(ln * 2 + mat) * D * 64; mu = a.in[I_MUX] + (size_t)(ln * 3 + 0) * 2 * D; }
            else if (mat < 4) { W = a.in[I_A1] + (size_t)(ln * 2 + (mat - 2)) * D * 64; mu = a.in[I_MUX] + (size_t)(ln * 3 + 1) * 2 * D; }
            else { W = a.in[I_G1] + (size_t)ln * D * 64; mu = a.in[I_MUX] + (size_t)(ln * 3 + 2) * 2 * D; }
            row_off = NPROJ + variant * LORA + 64 * mat; }
        else { const int jj = r - 1920; variant = jj / 64; item = jj % 64; N = 32;
            W = ln > 0 ? a.in[I_V1] + (size_t)(ln - 1) * D * 32 : nullptr; mu = ln > 0 ? a.in[I_MUV] + (size_t)(ln - 1) * 2 * D : nullptr; row_off = NPROJ + variant * LORA + 320; }
        return; }
    r -= 2 * IT_LORA;
    W = a.in[I_WOUT] + (size_t)ln * D * D; K = D; N = D; WT = (bf16*)(a.ws + WS_WOUT) + (size_t)(ln & 1) * D * D; item = r;
    mu = a.in[I_GATT] + (size_t)ln * 1024; variant = 3;
}
DI void bg_issue(CArgs& a, int l, int it, int lane, f32x4 (&nx)[4]) {
    const float* W; const float* mu; bf16* WT; int K, N, row_off, item, variant;
    bg_decode(a, l, it, W, mu, WT, K, N, row_off, item, variant);
    const int nblk = N >> 5, k0 = 32 * (item / nblk), n0 = 32 * (item % nblk);
    if (!W) {
#pragma unroll
        for (int i = 0; i < 4; ++i) nx[i] = (f32x4){0.f, 0.f, 0.f, 0.f};
        return; }
    const float* p = W + (size_t)(k0 + (lane >> 3)) * N + n0 + 4 * (lane & 7);
#pragma unroll
    for (int i = 0; i < 4; ++i) nx[i] = *(const f32x4*)(p + (size_t)(8 * i) * N);
}
DI void background_weights(CArgs& a, int l, LAS float* scr, int slot, int nslots, int lane) {
    const int total = BG_FFN + (l < 3 ? BG_LAYER : 0);
    f32x4 nx[4];
    int it = (l < 0 ? BG_FFN : 0) + slot;
    if (it < total) bg_issue(a, l, it, lane, nx);
#pragma unroll 1
    for (; it < total; it += nslots) {
        f32x4 v[4];
#pragma unroll
        for (int i = 0; i < 4; ++i) v[i] = nx[i];
        if (it + nslots < total) bg_issue(a, l, it + nslots, lane, nx);
        const float* W; const float* mu; bf16* WT; int K, N, row_off, item, variant;
        bg_decode(a, l, it, W, mu, WT, K, N, row_off, item, variant);
        const int nblk = N >> 5, k0 = 32 * (item / nblk), n0 = 32 * (item % nblk), rr = lane >> 3, cc = 4 * (lane & 7);
#pragma unroll
        for (int i = 0; i < 4; ++i) { const int kk = 8 * i + rr; float sc = 1.0f;
            if (mu) { if (variant == 3) { if (k0 < 1024) sc = mu[k0 + kk]; }
                      else { const float m0 = mu[k0 + kk], m1 = mu[K + k0 + kk]; sc = (variant == 0) ? (1.0f - m0 - m1) : (variant == 1 ? m0 : m1); } }
            LAS float* sp = scr + kk * 33 + cc; sp[0] = v[i].x * sc; sp[1] = v[i].y * sc; sp[2] = v[i].z * sc; sp[3] = v[i].w * sc; }
        asm volatile("s_waitcnt lgkmcnt(0)" ::: "memory");
        const int c = lane & 3;
#pragma unroll
        for (int j = 0; j < 2; ++j) { const int n = (lane >> 2) + 16 * j; const LAS float* sq = scr + (8 * c) * 33 + n;
            u32x4 o; o.x = pk2(sq[0 * 33], sq[1 * 33]); o.y = pk2(sq[2 * 33], sq[3 * 33]); o.z = pk2(sq[4 * 33], sq[5 * 33]); o.w = pk2(sq[6 * 33], sq[7 * 33]);
            *(u32x4*)(WT + (size_t)(row_off + n0 + n) * K + k0 + 8 * c) = o; }
        asm volatile("s_waitcnt lgkmcnt(0)" ::: "memory");
    }
}

DI void phase_prologue(CArgs& a, LAS unsigned char* lds, int tid, int lane, int wave, int G) {
    {   LAS float* sc = (LAS float*)(lds);
        LAS float* part = (LAS float*)(lds + 98304);
        bool have = false;
        for (int it = blockIdx.x; it < 4 * 96; it += G) {
            if (!have) {
#pragma unroll 1
                for (int i0 = tid; i0 < NSEQ * D; i0 += 512 * 8) { float cv[8];
#pragma unroll
                    for (int u = 0; u < 8; ++u) { const int i = i0 + 512 * u, s = i / D, k = i % D; cv[u] = s < 8 ? a.in[I_CP][s * D + k] : a.in[I_CS][(s - 8) * D + k]; }
#pragma unroll
                    for (int u = 0; u < 8; ++u) { const int i = i0 + 512 * u, s = i / D, k = i % D; const float c = cv[u]; sc[k * 12 + s] = c / (1.0f + __expf(-c)); } }
                __syncthreads(); have = true; }
            const int l = it / 96, n0 = (it % 96) * 128;
            const float* W = a.in[I_WADA] + (size_t)l * D * 12288 + n0 + 2 * lane;
            f32x2 acc[12];
#pragma unroll
            for (int s = 0; s < 12; ++s) acc[s] = (f32x2){0.f, 0.f};
#pragma unroll 16
            for (int k = wave * 256; k < wave * 256 + 256; ++k) { const f32x2 wv = *(const f32x2*)(W + (size_t)k * 12288); const LAS f32x4* sp = (const LAS f32x4*)(sc + k * 12); const f32x4 s0 = sp[0], s1 = sp[1], s2 = sp[2];
                acc[0] += s0.x * wv; acc[1] += s0.y * wv; acc[2] += s0.z * wv; acc[3] += s0.w * wv; acc[4] += s1.x * wv; acc[5] += s1.y * wv; acc[6] += s1.z * wv; acc[7] += s1.w * wv;
                acc[8] += s2.x * wv; acc[9] += s2.y * wv; acc[10] += s2.z * wv; acc[11] += s2.w * wv; }
#pragma unroll
            for (int s = 0; s < 12; ++s) *(LAS f32x2*)(part + (wave * 12 + s) * 128 + 2 * lane) = acc[s];
            __syncthreads();
            for (int o = tid; o < 12 * 128; o += 512) { const int s = o / 128, c = o % 128; float v = a.in[I_BADA][l * 12288 + n0 + c];
#pragma unroll
                for (int w = 0; w < 8; ++w) v += part[(w * 12 + s) * 128 + c];
                ((float*)(a.ws + WS_MOD))[(size_t)(l * NSEQ + s) * 12288 + n0 + c] = v; }
            __syncthreads();
        }
        __syncthreads();
    }
    {   LAS float* scr = (LAS float*)(lds + wave * L_TRS);
        const int gw = blockIdx.x * 8 + wave, NGW = G * 8;
        background_weights(a, -1, scr, gw, NGW, lane);
    }
    {   bf16* lup = (bf16*)(a.ws + WS_LUP);
        for (int e = blockIdx.x * 512 + tid; e < 4 * LUP_LAYER; e += G * 512) { const int l = e / LUP_LAYER, r = e % LUP_LAYER; float v;
            if (r < LUP_A2) { const int d = r >> 16, ch = (r & 65535) >> 6, k = r & 63; v = a.in[I_W2][((size_t)(l * 2 + d) * 64 + k) * 1024 + ch]; }
            else if (r < LUP_G2) { const int q = r - LUP_A2, d = q >> 16, ch = (q & 65535) >> 6, k = q & 63; v = a.in[I_A2][((size_t)(l * 2 + d) * 64 + k) * 1024 + ch]; }
            else if (r < LUP_V2) { const int q = r - LUP_G2, ch = q >> 6, k = q & 63; v = a.in[I_G2][((size_t)l * 64 + k) * 1024 + ch]; }
            else { const int q = r - LUP_V2, ch = q >> 5, k = q & 31; v = l > 0 ? a.in[I_V2][((size_t)(l - 1) * 32 + k) * 1024 + ch] : 0.f; }
            lup[e] = (bf16)f2bf(v); }
    }
}

DI void phase_resnorm(CArgs& a, LAS unsigned char* lds, int l, int mode, int tid, int lane, int wave, int G) {
    LAS float* prm = (LAS float*)(lds + L_PRM);
    const bf16* src = mode == 1 ? (const bf16*)(a.ws + WS_RBUF) : (const bf16*)(a.ws + WS_EX);
    bf16* hb = (bf16*)(a.ws + WS_HB);
    const bool do_h = (mode != 2) || (l < 3);
    const int ln = (mode == 2) ? l + 1 : l;
    const int rpb = (TOK + G - 1) / G, mb = min((int)blockIdx.x * rpb, TOK), me = min(mb + rpb, TOK);
    for (int m0 = mb; m0 < me; ) {
        int s, t0, T; tokinfo(m0, s, t0, T);
        const int mend = min(me, m0 - t0 + T);
        __syncthreads();
#pragma unroll
        for (int i = tid; i < D; i += 512) {
            float gpost = 0.f, gate = 0.f, gpre = 0.f, sc = 0.f, sh = 0.f;
            if (mode == 1) { gpost = a.in[I_GPOSTMIX][l * D + i]; gate = mod_ptr(a, l, s, 2)[i]; gpre = a.in[I_GPREFFN][l * D + i]; sc = mod_ptr(a, l, s, 4)[i]; sh = mod_ptr(a, l, s, 3)[i]; }
            else { if (mode == 2) { gpost = a.in[I_GPOSTFFN][l * D + i]; gate = mod_ptr(a, l, s, 5)[i]; }
                   if (do_h) { gpre = a.in[I_GPREMIX][ln * D + i]; sc = mod_ptr(a, ln, s, 1)[i]; sh = mod_ptr(a, ln, s, 0)[i]; } }
            prm[i] = gpost; prm[D + i] = gate; prm[2 * D + i] = gpre; prm[3 * D + i] = sc; prm[4 * D + i] = sh; }
        __syncthreads();
        const bool xin_f32 = (mode == 0) || (mode == 1 && l == 0);
        const bool xout_f32 = (mode == 2 && l == DEPTH - 1);
        bf16* xb = (bf16*)(a.ws + WS_XB);
#define RN_LOAD(mm_) do { if (xin_f32) { const float* xp_ = (mm_) < TP ? a.in[I_XP] + (size_t)(mm_) * D : a.in[I_XS] + (size_t)((mm_) - TP) * D; \
                _Pragma("unroll") for (int j = 0; j < 8; ++j) xn[j] = __builtin_nontemporal_load((const f32x4*)xp_ + lane + 64 * j); } \
            else { _Pragma("unroll") for (int j = 0; j < 8; ++j) { const u32x2 w_ = __builtin_nontemporal_load((const u32x2*)(xb + (size_t)(mm_) * D) + lane + 64 * j); xn[j] = (f32x4){bflo(w_.x), bfhi(w_.x), bflo(w_.y), bfhi(w_.y)}; } } \
            if (mode != 0) { _Pragma("unroll") for (int j = 0; j < 8; ++j) sn[j] = __builtin_nontemporal_load((const u32x2*)(src + (size_t)(mm_) * D + 4 * (lane + 64 * j))); } \
            if (mode == 1) { qn0 = *(const f32x4*)(ssqa + (size_t)(mm_) * 8); qn1 = *(const f32x4*)(ssqa + (size_t)(mm_) * 8 + 4); } } while (0)
        const float* ssqa = (const float*)(a.ws + WS_SSQ);
        f32x4 qn0 = (f32x4){0.f, 0.f, 0.f, 0.f}, qn1 = qn0;
        f32x4 xn[8]; u32x2 sn[8];
#pragma unroll
        for (int j = 0; j < 8; ++j) sn[j] = (u32x2){0u, 0u};
        if (m0 + wave < mend) RN_LOAD(m0 + wave);
#pragma unroll 1
        for (int m = m0 + wave; m < mend; m += 8) {
            f32x4 x[8]; u32x2 sv[8];
#pragma unroll
            for (int j = 0; j < 8; ++j) { x[j] = xn[j]; sv[j] = sn[j]; }
            const float eps1 = (mode == 1) ? NORM_EPS * (((qn0.x + qn0.y) + (qn0.z + qn0.w) + (qn1.x + qn1.y) + (qn1.z + qn1.w)) * (1.0f / 1024.0f) + NORM_EPS) : NORM_EPS;
            if (m + 8 < mend) RN_LOAD(m + 8);
            if (mode != 0) {
                f32x4 v[8]; float ss = 0.f;
#pragma unroll
                for (int j = 0; j < 8; ++j) { const u32x2 w = sv[j]; v[j] = (f32x4){bflo(w.x), bfhi(w.x), bflo(w.y), bfhi(w.y)};
                    ss += (v[j].x * v[j].x + v[j].y * v[j].y) + (v[j].z * v[j].z + v[j].w * v[j].w); }
                const float rstd = __builtin_amdgcn_rsqf(wave_sum_dpp(ss) * (1.0f / D) + eps1);
#pragma unroll
                for (int j = 0; j < 8; ++j) { const f32x4 gp = *(const LAS f32x4*)(prm + 4 * (lane + 64 * j)), gt = *(const LAS f32x4*)(prm + D + 4 * (lane + 64 * j));
                    x[j] = x[j] + gt * (v[j] * rstd * gp);
                    if (xout_f32) __builtin_nontemporal_store(x[j], (f32x4*)(a.out + (size_t)m * D) + lane + 64 * j);
                    else { u32x2 w; w.x = pk2(x[j].x, x[j].y); w.y = pk2(x[j].z, x[j].w); __builtin_nontemporal_store(w, (u32x2*)(xb + (size_t)m * D) + lane + 64 * j); } }
            }
            if (do_h) {
                float ss = 0.f;
#pragma unroll
                for (int j = 0; j < 8; ++j) ss += (x[j].x * x[j].x + x[j].y * x[j].y) + (x[j].z * x[j].z + x[j].w * x[j].w);
                const float rstd = __builtin_amdgcn_rsqf(wave_sum_dpp(ss) * (1.0f / D) + NORM_EPS);
#pragma unroll
                for (int j = 0; j < 8; ++j) { const int c = 4 * (lane + 64 * j); const f32x4 gp = *(const LAS f32x4*)(prm + 2 * D + c), sc = *(const LAS f32x4*)(prm + 3 * D + c), sh = *(const LAS f32x4*)(prm + 4 * D + c);
                    const f32x4 h = x[j] * rstd * gp * (1.0f + sc) + sh; u32x2 w; w.x = pk2(h.x, h.y); w.y = pk2(h.z, h.w); *(u32x2*)(hb + (size_t)m * D + c) = w;
                    if ((j & 1) == 1) asm volatile("" ::: "memory"); }
            }
        }
#undef RN_LOAD
        m0 = mend;
    }
}
#define MFMA32(a, b, c) __builtin_amdgcn_mfma_f32_32x32x16_bf16((a), (b), (c), 0, 0, 0)
DI int v_off(int row, int ch) { return 256 * row + 16 * (ch ^ (((row & 3) << 2) | ((row >> 2) & 3))); }
DI s16x4 tr_read(const LAS unsigned char* p) { return __builtin_amdgcn_ds_read_tr16_b64_v4i16((LAS s16x4*)p); }
DI bf16x8 pack8(const f32x16& x, int s) {
    u32x4 p; p.x = pk2(x[8 * s + 0], x[8 * s + 1]); p.y = pk2(x[8 * s + 2], x[8 * s + 3]); p.z = pk2(x[8 * s + 4], x[8 * s + 5]); p.w = pk2(x[8 * s + 6], x[8 * s + 7]);
    return __builtin_bit_cast(bf16x8, p);
}
template <int V> struct IntC { static constexpr int value = V; };
template <int QH>
DI void att_tile(f32x16 (&o)[4], float& mrun, float& lrun, const LAS unsigned char* kt, const LAS unsigned char* vt, const LAS unsigned char* qt, const int (&vofs)[4][2],
                 const LAS float* bp, int dv, int rq, int h, float scale) {
    constexpr int FB = 1 - QH, NB = QH, FV0 = QH ? 12 : 0, FS2 = QH ? 1 : 0;
#define LIVE(kb_, i_) ((kb_) == NB || ((i_) >= FV0 && (i_) < FV0 + 4))
    f32x16 st[2];
#pragma unroll
    for (int kb = 0; kb < 2; ++kb)
#pragma unroll
        for (int i = 0; i < 16; ++i) st[kb][i] = 0.f;
    bf16x8 qf[8], kf[8][2];
#define QK_LOAD(ks_) do { qf[ks_] = *(const LAS bf16x8*)(qt + v_off(rq, 2 * (ks_) + h)); kf[ks_][0] = *(const LAS bf16x8*)(kt + v_off(rq, 2 * (ks_) + h)); kf[ks_][1] = *(const LAS bf16x8*)(kt + v_off(32 + rq, 2 * (ks_) + h)); } while (0)
    __builtin_amdgcn_sched_barrier(0);
    QK_LOAD(0);
    __builtin_amdgcn_sched_barrier(0);
#pragma unroll
    for (int ks = 0; ks < 8; ++ks) {
        st[0] = MFMA32(kf[ks][0], qf[ks], st[0]); st[1] = MFMA32(kf[ks][1], qf[ks], st[1]);
        if (ks + 1 < 8) QK_LOAD(ks + 1);
        __builtin_amdgcn_sched_barrier(0); }
#undef QK_LOAD
    bf16x8 vf[12];
#define PV_KB(g_) (((g_) >> 2) == 2 ? FB : NB)
#define PV_S2(g_) (((g_) >> 2) == 2 ? FS2 : ((g_) >> 2))
#define PV_LOAD(g_) do { const int kb_ = PV_KB(g_), s2_ = PV_S2(g_), db_ = (g_) & 3; \
        const s16x4 lo_ = tr_read(vt + vofs[db_][0] + 256 * (32 * kb_ + 16 * s2_)), hi_ = tr_read(vt + vofs[db_][1] + 256 * (32 * kb_ + 16 * s2_)); \
        vf[g_] = __builtin_shufflevector(lo_, hi_, 0, 1, 2, 3, 4, 5, 6, 7); } while (0)
    PV_LOAD(0); PV_LOAD(1);
    __builtin_amdgcn_sched_barrier(0);
    float mx = -1e30f;
#pragma unroll
    for (int kb = 0; kb < 2; ++kb) {
        float bv[16];
#pragma unroll
        for (int i = 0; i < 16; ++i) bv[i] = LIVE(kb, i) ? bp[32 * kb + (i & 3) + 8 * (i >> 2)] : 0.f;
#pragma unroll
        for (int i = 0; i < 16; ++i) if (LIVE(kb, i)) { const int cc = 32 * kb + (i & 3) + 8 * (i >> 2); const bool valid = (unsigned)(cc + dv) < 16u;
            const float sb = fmaf(st[kb][i], scale, bv[i]); const float sv2 = valid ? sb : -1e30f; st[kb][i] = sv2; mx = fmaxf(mx, sv2); }
        __builtin_amdgcn_sched_barrier(0); }
    mx = fmaxf(mx, __shfl_xor(mx, 32));
    const float mnew = fmaxf(mrun, mx), alpha = __builtin_amdgcn_exp2f(mrun - mnew);
    float psum = 0.f;
#pragma unroll
    for (int kb = 0; kb < 2; ++kb)
#pragma unroll
        for (int i = 0; i < 16; ++i) { if (LIVE(kb, i)) { const float p = __builtin_amdgcn_exp2f(st[kb][i] - mnew); st[kb][i] = p; psum += p; } else st[kb][i] = 0.f; }
    lrun = lrun * alpha + psum; mrun = mnew;
#pragma unroll
    for (int db = 0; db < 4; ++db)
#pragma unroll
        for (int i = 0; i < 16; ++i) o[db][i] *= alpha;
    __builtin_amdgcn_sched_barrier(0);
#pragma unroll
    for (int g = 0; g < 12; ++g) { const bf16x8 pf = pack8(st[PV_KB(g)], PV_S2(g));
        o[g & 3] = MFMA32(vf[g], pf, o[g & 3]);
        if (g + 2 < 12) PV_LOAD(g + 2);
        __builtin_amdgcn_sched_barrier(0); }
#undef PV_LOAD
#undef PV_KB
#undef PV_S2
#undef LIVE
}
DI void phase_attention(CArgs& a, LAS unsigned char* lds, int l, int tid, int lane, int wave, int G) {
    const bf16* qkv = (const bf16*)(a.ws + WS_QKV);
    bf16* mixin = (bf16*)(a.ws + WS_MIXIN);
    float* ssqo = (float*)(a.ws + WS_SSQ);
    LAS float* bt = (LAS float*)(lds + L_BIAS);
    const int rq = lane & 31, h = lane >> 5;
    const float scale = 0.08838834764831845f * 1.4426950408889634f;
    int vofs[4][2];
    { const int g16 = lane & 15, qq = g16 >> 2, pp = g16 & 3, blk = (lane >> 4) & 1;
#pragma unroll
      for (int db = 0; db < 4; ++db)
#pragma unroll
          for (int hi = 0; hi < 2; ++hi) vofs[db][hi] = v_off(4 * h + qq + 8 * hi, 4 * db + 2 * blk + (pp >> 1)) + 8 * (pp & 1); }
    const int skey0 = tid >> 4, sch = tid & 15;
    for (int u = blockIdx.x; u < (TOK / 256) * NAH; u += G) {
        const int head = u & 7, m0 = (u >> 3) * 256; int s, t0, T; tokinfo(m0, s, t0, T);
        const int r0 = t0 >> 6, rows = T >> 6, sbase = m0 - t0;
        const int r = r0 + (wave >> 1), qh = wave & 1;
        const int rs = min(max(r - 4, 0), rows - 8);
        const int klo = min(max(r0 - 4, 0), rows - 8), khi = min(max(r0 + 3 - 4, 0), rows - 8) + 8, nt = khi - klo;
        const int q = 32 * qh + rq, mq = m0 + 64 * (wave >> 1) + q;
        const int cs = min(max(q - 8, 0), 48);
        __syncthreads();
        LAS unsigned char* qt = lds + 65536 + wave * 8192;
        u32x4 sk[2][2], sv[2][2];
#define KV_FETCH(set_, row_) do { const bf16* kp_ = qkv + (size_t)(sbase + (row_) * 64 + skey0) * NQKV + head * 128 + sch * 8; \
            _Pragma("unroll") for (int i_ = 0; i_ < 2; ++i_) { sk[set_][i_] = *(const u32x4*)(kp_ + (size_t)(32 * i_) * NQKV + 1024); sv[set_][i_] = *(const u32x4*)(kp_ + (size_t)(32 * i_) * NQKV + 2048); } } while (0)
        {   const float bias_v = a.in[I_RPB][(size_t)(l * NAH + head) * 465 + min(tid, 15 * 31 - 1)];
            u32x4 qreg[8];
            const bf16* qp = qkv + (size_t)(m0 + 64 * (wave >> 1) + 32 * qh) * NQKV + head * 128;
#pragma unroll
            for (int i = 0; i < 8; ++i) { const int p = i * 64 + lane, row = p >> 4, ch = p & 15; qreg[i] = *(const u32x4*)(qp + (size_t)row * NQKV + ch * 8); }
            KV_FETCH(0, klo);
            KV_FETCH(1, klo + 1);
            __builtin_amdgcn_sched_barrier(0);
            if (tid < 15 * 31) bt[tid] = 1.4426950408889634f * bias_v;
#pragma unroll
            for (int i = 0; i < 8; ++i) { const int p = i * 64 + lane, row = p >> 4, ch = p & 15; *(LAS u32x4*)(qt + v_off(row, ch)) = qreg[i]; }
#pragma unroll
            for (int i = 0; i < 2; ++i) { *(LAS u32x4*)(lds + v_off(skey0 + 32 * i, sch)) = sk[0][i]; *(LAS u32x4*)(lds + 16384 + v_off(skey0 + 32 * i, sch)) = sv[0][i]; }
        }
        f32x16 o[4];
#pragma unroll
        for (int db = 0; db < 4; ++db)
#pragma unroll
            for (int i = 0; i < 16; ++i) o[db][i] = 0.f;
        float mrun = -1e30f, lrun = 0.f;
        __syncthreads();
        auto tile_loop = [&](auto qhc) __attribute__((always_inline)) {
        constexpr int QH = decltype(qhc)::value;
#pragma unroll 1
        for (int it0 = 0; it0 < nt; it0 += 2) {
#pragma unroll
        for (int half = 0; half < 2; ++half) {
            const int it = it0 + half; if (it >= nt) break;
            const int R = klo + it;
            LAS unsigned char* kt = lds + half * 32768; LAS unsigned char* vt = kt + 16384;
            if (it + 2 < nt) KV_FETCH(half, R + 2);
            if (R >= rs && R < rs + 8) {
                int dv = 4 * h - cs; asm volatile("" : "+v"(dv));
                const LAS float* bp = bt + (R - r + 7) * 31 + (4 * h - q + 15);
                att_tile<QH>(o, mrun, lrun, kt, vt, qt, vofs, bp, dv, rq, h, scale);
            }
            if (it + 1 < nt) { LAS unsigned char* kn = lds + (1 - half) * 32768;
#pragma unroll
                for (int i = 0; i < 2; ++i) { *(LAS u32x4*)(kn + v_off(skey0 + 32 * i, sch)) = sk[1 - half][i]; *(LAS u32x4*)(kn + 16384 + v_off(skey0 + 32 * i, sch)) = sv[1 - half][i]; } }
            __syncthreads();
        } }
        };
        if (qh == 0) tile_loop(IntC<0>{}); else tile_loop(IntC<1>{});
#undef KV_FETCH
        const float inv = 1.0f / (lrun + __shfl_xor(lrun, 32));
        float ss = 0.f;
#pragma unroll
        for (int db = 0; db < 4; ++db)
#pragma unroll
            for (int i = 0; i < 16; ++i) { o[db][i] *= inv; ss += o[db][i] * o[db][i]; }
        ss += __shfl_xor(ss, 32);
        if (lane < 32) ssqo[(size_t)mq * NAH + head] = ss;
        {   LAS unsigned char* ost = lds + wave * 16384;
#pragma unroll
            for (int db = 0; db < 4; ++db)
#pragma unroll
                for (int g4 = 0; g4 < 4; ++g4) { const int d0 = 32 * db + 8 * g4 + 4 * h;
                    u32x2 w; w.x = pk2(o[db][4 * g4 + 0], o[db][4 * g4 + 1]); w.y = pk2(o[db][4 * g4 + 2], o[db][4 * g4 + 3]);
                    *(LAS u32x2*)(ost + rq * 272 + d0 * 2) = w; }
            bf16* obase = mixin + (size_t)(m0 + 64 * (wave >> 1) + 32 * qh) * D + head * 128;
            u32x4 orow[8];
#pragma unroll
            for (int i = 0; i < 8; ++i) { const int p = i * 64 + lane, row = p >> 4, ch = p & 15; orow[i] = *(const LAS u32x4*)(ost + row * 272 + ch * 16); }
            __builtin_amdgcn_sched_barrier(0);
#pragma unroll
            for (int i = 0; i < 8; ++i) { const int p = i * 64 + lane, row = p >> 4, ch = p & 15; *(u32x4*)(obase + (size_t)row * D + ch * 8) = orow[i]; }
        }
    }
}
#define MFMA16(a, b, c) __builtin_amdgcn_mfma_f32_16x16x32_bf16((a), (b), (c), 0, 0, 0)
constexpr int ACT_LD = 360;
constexpr int PP_OFF = 46080;
enum { PP_MUR0 = 0, PP_MUR1, PP_MUK0, PP_MUK1, PP_MUV0, PP_MUV1, PP_W00, PP_W01, PP_A00, PP_A01, PP_V0, PP_KK, PP_KA, PP_RK };
DI void phase_prep(CArgs& a, LAS unsigned char* lds, int l, int tid, int lane, int wave, int G) {
    const bf16* rcg = (const bf16*)(a.ws + WS_RBUF);
    const bf16* lb = (const bf16*)(a.ws + WS_LORA);
    LAS bf16* act = (LAS bf16*)lds;
    LAS float* prm = (LAS float*)(lds + PP_OFF);
    const bf16* lup = (const bf16*)(a.ws + WS_LUP) + (size_t)l * LUP_LAYER;
    unsigned short* o_r = (unsigned short*)(a.ws + WS_QKV); unsigned short* o_k = o_r + PLANE; unsigned short* o_v = o_k + PLANE;
    unsigned short* o_lw = (unsigned short*)(a.ws + WS_HB);
    unsigned short* o_a = (unsigned short*)(a.ws + WS_EX);
    unsigned short* o_g = (unsigned short*)(a.ws + WS_G);
    unsigned short* vfirst = (unsigned short*)(a.ws + WS_VFIRST);
    float* o_kn = (float*)(a.ws + WS_KN); float* o_bon = o_kn + (size_t)TOK * 16;
    const int fr = lane & 15, fq = lane >> 4;
    __syncthreads();
    {
        float pv[28];
#pragma unroll
        for (int k = 0; k < 28; ++k) { const int v = k >> 1, c = tid + 512 * (k & 1); float x;
            if (v < 6) x = a.in[I_MURKV][(size_t)(l * 3 + (v >> 1)) * 2048 + (v & 1) * 1024 + c];
            else if (v < 8) x = a.in[I_W0][(size_t)l * 2048 + (v - 6) * 1024 + c];
            else if (v < 10) x = a.in[I_A0][(size_t)l * 2048 + (v - 8) * 1024 + c];
            else if (v == 10) x = a.in[I_V0][(size_t)max(l - 1, 0) * 1024 + c];
            else if (v == 11) x = a.in[I_KK][(size_t)l * 1024 + c];
            else if (v == 12) x = a.in[I_KA][(size_t)l * 1024 + c];
            else x = a.in[I_RK][(size_t)l * 1024 + c];
            pv[k] = x; }
        __builtin_amdgcn_sched_barrier(0);
#pragma unroll
        for (int k = 0; k < 28; ++k) { const int v = k >> 1, c = tid + 512 * (k & 1); prm[v * 1024 + c] = (v == 10 && l == 0) ? 0.f : pv[k]; }
    }
    for (int tile = blockIdx.x; tile < TOK / 32; tile += G) {
        const int m0 = tile * 32; int s, t0, T; tokinfo(m0, s, t0, T);
        __syncthreads();
        {
            u32x4 aw[3], awp[3], awn[3];
#pragma unroll
            for (int k = 0; k < 3; ++k) { const int it = min(tid + 512 * k, 32 * 44 - 1), i = it / 44, c = 8 * (it % 44), m = m0 + i, t = t0 + i;
                const bf16* p0 = lb + (size_t)m * NLB + c;
                aw[k] = *(const u32x4*)p0; awp[k] = *(const u32x4*)(p0 + (t > 0 ? -NLB : 0) + LORA); awn[k] = *(const u32x4*)(p0 + (t < T - 1 ? NLB : 0) + 2 * LORA); }
            __builtin_amdgcn_sched_barrier(0);
#pragma unroll
            for (int k = 0; k < 3; ++k) { const int it = tid + 512 * k; if (it < 32 * 44) { const int i = it / 44, c = 8 * (it % 44), t = t0 + i;
                const u32x4 w = aw[k], wp = awp[k], wn = awn[k];
                const float pm = t > 0 ? 1.f : 0.f, nm = t < T - 1 ? 1.f : 0.f;
                float v[8];
#pragma unroll
                for (int j = 0; j < 4; ++j) { v[2 * j] = bflo(w[j]) + pm * bflo(wp[j]) + nm * bflo(wn[j]); v[2 * j + 1] = bfhi(w[j]) + pm * bfhi(wp[j]) + nm * bfhi(wn[j]); }
                if (c < 128) {
#pragma unroll
                    for (int j = 0; j < 8; ++j) v[j] = tanhf_(v[j]); }
                else if (c >= 256 && c < 320) {
#pragma unroll
                    for (int j = 0; j < 8; ++j) v[j] = sigmoidf_(v[j]); }
                u32x4 ow; ow.x = pkbf(v[0], v[1]); ow.y = pkbf(v[2], v[3]); ow.z = pkbf(v[4], v[5]); ow.w = pkbf(v[6], v[7]);
                *(LAS u32x4*)(act + i * ACT_LD + c) = ow; } }
        }
        __syncthreads();
        LAS float* hpart = (LAS float*)(lds + PP_OFF + 57344) + wave * 192;
#pragma unroll 1
        for (int hc = 0; hc < 4; ++hc) {
            const int hp = hc >> 1, cgl = hc & 1, cg = hc;
            const int cbase = 128 * wave + 32 * cg, c0 = cbase + 8 * fq;
            const int wrow0 = cbase + 8 * (fr >> 2) + (fr & 3);
            bf16x8 wf[6][2][2];
#pragma unroll
            for (int mm = 0; mm < 6; ++mm) { const bf16* wt = lup + (mm < 2 ? LUP_W2 + mm * 65536 : mm < 4 ? LUP_A2 + (mm - 2) * 65536 : mm == 4 ? LUP_G2 : LUP_V2); const int kw = (mm == 5) ? 32 : 64;
#pragma unroll
                for (int ks = 0; ks < (mm == 5 ? 1 : 2); ++ks)
#pragma unroll
                    for (int n = 0; n < 2; ++n) wf[mm][ks][n] = *(const bf16x8*)(wt + (size_t)(wrow0 + 4 * n) * kw + 32 * ks + 8 * fq); }
#pragma unroll 1
            for (int tb = 0; tb < 2; ++tb) {
            const int i = 16 * tb + fr, m = m0 + i, t = t0 + i;
            u32x4 cur[10];
            const size_t ob = ((size_t)(4 * wave + cg) * TOK + m) * 32 + 8 * fq;
            {   const bf16* rp_ = rcg + ob; const int tp_ = t > 0 ? -32 : 0, tn_ = t < T - 1 ? 32 : 0;
                cur[0] = *(const u32x4*)rp_; cur[1] = *(const u32x4*)(rp_ + PLANE); cur[2] = *(const u32x4*)(rp_ + 2 * PLANE);
                cur[3] = *(const u32x4*)(rp_ + tp_); cur[4] = *(const u32x4*)(rp_ + tp_ + PLANE); cur[5] = *(const u32x4*)(rp_ + tp_ + 2 * PLANE);
                cur[6] = *(const u32x4*)(rp_ + tn_); cur[7] = *(const u32x4*)(rp_ + tn_ + PLANE); cur[8] = *(const u32x4*)(rp_ + tn_ + 2 * PLANE);
                cur[9] = l > 0 ? *(const u32x4*)(vfirst + ob) : (u32x4){0u, 0u, 0u, 0u}; }
            float pss = 0.f, pb0 = 0.f, pb1 = 0.f;
            const LAS bf16* arow = act + i * ACT_LD + 8 * fq;
#define LUP(name, mm) f32x4 name[2] = {(f32x4){0.f, 0.f, 0.f, 0.f}, (f32x4){0.f, 0.f, 0.f, 0.f}}; { _Pragma("unroll") for (int ks_ = 0; ks_ < ((mm) == 5 ? 1 : 2); ++ks_) { const bf16x8 af_ = *(const LAS bf16x8*)(arow + 64 * (mm) + 32 * ks_); \
                _Pragma("unroll") for (int n_ = 0; n_ < 2; ++n_) name[n_] = MFMA16(wf[mm][ks_][n_], af_, name[n_]); } }
            const LAS float* pp = prm + c0;
#define PRM8(name, vi_) float name[8]; { const f32x4 x0_ = *(const LAS f32x4*)(pp + (vi_) * 1024), x1_ = *(const LAS f32x4*)(pp + (vi_) * 1024 + 4); \
                name[0] = x0_[0]; name[1] = x0_[1]; name[2] = x0_[2]; name[3] = x0_[3]; name[4] = x1_[0]; name[5] = x1_[1]; name[6] = x1_[2]; name[7] = x1_[3]; }
#define BF8(dst, src, msk) float dst[8]; { _Pragma("unroll") for (int j_ = 0; j_ < 4; ++j_) { dst[2 * j_] = (msk) * bflo(src[j_]); dst[2 * j_ + 1] = (msk) * bfhi(src[j_]); } }
#define ST8H(ptr, arr_) do { u32x4 w_; w_[0] = pkh2(arr_[0], arr_[1]); w_[1] = pkh2(arr_[2], arr_[3]); w_[2] = pkh2(arr_[4], arr_[5]); w_[3] = pkh2(arr_[6], arr_[7]); __builtin_nontemporal_store(w_, (u32x4*)(ptr)); } while (0)
            const float pm = t > 0 ? 1.f : 0.f, nm = t < T - 1 ? 1.f : 0.f;
            float rr[8], kk[8];
            {   PRM8(m0_, PP_MUR0) PRM8(m1_, PP_MUR1) BF8(c_, cur[0], 1.f) BF8(p_, cur[3], pm) BF8(n_, cur[6], nm)
#pragma unroll
                for (int j = 0; j < 8; ++j) rr[j] = c_[j] + m0_[j] * (p_[j] - c_[j]) + m1_[j] * (n_[j] - c_[j]);
                ST8H(o_r + ob, rr); }
            {   PRM8(m0_, PP_MUK0) PRM8(m1_, PP_MUK1) BF8(c_, cur[1], 1.f) BF8(p_, cur[4], pm) BF8(n_, cur[7], nm)
#pragma unroll
                for (int j = 0; j < 8; ++j) kk[j] = c_[j] + m0_[j] * (p_[j] - c_[j]) + m1_[j] * (n_[j] - c_[j]);
                ST8H(o_k + ob, kk); }
            {   float vv[8]; PRM8(m0_, PP_MUV0) PRM8(m1_, PP_MUV1) BF8(c_, cur[2], 1.f) BF8(p_, cur[5], pm) BF8(n_, cur[8], nm)
#pragma unroll
                for (int j = 0; j < 8; ++j) vv[j] = c_[j] + m0_[j] * (p_[j] - c_[j]) + m1_[j] * (n_[j] - c_[j]);
                if (l == 0) { ST8H(vfirst + ob, vv); }
                else { PRM8(v0_, PP_V0) LUP(accv, 5)
#pragma unroll
                    for (int j = 0; j < 8; ++j) { const float f = (j & 1) ? hhi(cur[9][j >> 1]) : hlo(cur[9][j >> 1]); const float gte = sigmoidf_(v0_[j] + accv[j >> 2][j & 3]); vv[j] = vv[j] + (f - vv[j]) * gte; } }
                ST8H(o_v + ob, vv); }
            {   PRM8(ka_, PP_KA) PRM8(rk_, PP_RK)
#pragma unroll
                for (int d = 0; d < 2; ++d) { float lw[8], av[8]; PRM8(w0_, PP_W00 + d) PRM8(a0_, PP_A00 + d) LUP(accw, d) LUP(acca, 2 + d)
#pragma unroll
                    for (int j = 0; j < 8; ++j) { lw[j] = -0.6065306597126334f * sigmoidf_(w0_[j] + accw[j >> 2][j & 3]); av[j] = sigmoidf_(a0_[j] + acca[j >> 2][j & 3]);
                        const float pbv = rr[j] * (kk[j] * (1.0f + (av[j] - 1.0f) * ka_[j])) * rk_[j]; if (d == 0) pb0 += pbv; else pb1 += pbv; }
                    ST8H(o_lw + (size_t)d * PLANE + ob, lw); ST8H(o_a + (size_t)d * PLANE + ob, av); } }
            { LUP(accg, 4) u32x4 w; w.x = pkh2(accg[0][0], accg[0][1]); w.y = pkh2(accg[0][2], accg[0][3]); w.z = pkh2(accg[1][0], accg[1][1]); w.w = pkh2(accg[1][2], accg[1][3]);
              *(u32x4*)(o_g + ob) = w; }
            {   PRM8(kkp_, PP_KK)
#pragma unroll
                for (int j = 0; j < 8; ++j) { const float x = kk[j] * kkp_[j]; pss += x * x; } }
#undef PRM8
#undef BF8
#undef ST8H
#undef LUP
            {   float q0 = pss, q1 = pb0, q2 = pb1;
                q0 += __shfl_xor(q0, 16); q0 += __shfl_xor(q0, 32); q1 += __shfl_xor(q1, 16); q1 += __shfl_xor(q1, 32); q2 += __shfl_xor(q2, 16); q2 += __shfl_xor(q2, 32);
                LAS float* hq = hpart + (tb * 16 + fr) * 3;
                if (cgl == 0) { if (lane < 16) { hq[0] = q0; hq[1] = q1; hq[2] = q2; } }
                else if (lane < 16) { q0 += hq[0]; q1 += hq[1]; q2 += hq[2];
                    const size_t o = (size_t)m * 16 + 2 * wave + hp; o_kn[o] = __builtin_amdgcn_rsqf(fmaxf(q0, 1e-24f)); o_bon[o] = q1; o_bon[(size_t)TOK * 16 + o] = q2; } }
            }
        }
    }
}

constexpr int NAT_LD = 144, NAT_ARR = 32 * NAT_LD, CHM_LD = 80, CHM_ARR = 64 * CHM_LD;
constexpr int NAT_ALL = 4 * NAT_ARR, CHM_ALL = 4 * CHM_ARR, NC_BUF = NAT_ALL + CHM_ALL;
constexpr int O_RAW = 0, O_BUF = 20480;
template <int DB> struct SlotMap { static constexpr int O_SM = O_BUF + DB * NC_BUF, O_FLAG = O_SM + DB * 512, BYTES = O_FLAG + 64; };
constexpr int SLOT0 = SlotMap<2>::BYTES, SLOT1 = SlotMap<1>::BYTES;
enum { F_RAW = 0, F_ST0 = 1, F_ST1 = 2, F_CONS = 3 };
DI bf16x8 packc(const f32x16& x, int s) { u32x4 p; p.x = pkbf(x[8 * s + 0], x[8 * s + 1]); p.y = pkbf(x[8 * s + 2], x[8 * s + 3]); p.z = pkbf(x[8 * s + 4], x[8 * s + 5]); p.w = pkbf(x[8 * s + 6], x[8 * s + 7]); return __builtin_bit_cast(bf16x8, p); }
DI void spin_ge(volatile LAS unsigned* f, unsigned v) { unsigned sp = 0; while (*f < v && ++sp < (1u << 24)) __builtin_amdgcn_s_sleep(1); asm volatile("" ::: "memory"); }
DI bf16x8 ld_perm(const LAS unsigned char* row, int s, int h) {
    const s16x4 lo = *(const LAS s16x4*)(row + 2 * (16 * s + 4 * h)), hi = *(const LAS s16x4*)(row + 2 * (16 * s + 8 + 4 * h));
    return __builtin_shufflevector(lo, hi, 0, 1, 2, 3, 4, 5, 6, 7);
}
DI void scan_dma(const unsigned short* const (&src)[5], LAS unsigned char* raw, size_t tokoff, int d, int lane) {
    int tl = lane >> 3, pc = (lane & 7) * 8; asm volatile("" : "+v"(tl), "+v"(pc));
#pragma unroll
    for (int rg = 0; rg < 4; ++rg) { const int R = 8 * rg + tl; const size_t lo = ((size_t)(pc >> 5) * TOK + tokoff + (size_t)(d ? 31 - R : R)) * 32 + (pc & 31);
#pragma unroll
        for (int arr = 0; arr < 5; ++arr)
            __builtin_amdgcn_global_load_lds((const unsigned*)(src[arr] + lo), (LAS unsigned*)(raw + (arr * 32 + rg * 8) * 128), 16, 0, 0); }
}
DI float scan_stage(const LAS unsigned char* raw, LAS unsigned char* nat, LAS unsigned char* chm, const LAS float* kns, int lane, int o0, int o1, float E, float kkc, float kac) {
    const LAS unsigned short* rw = (const LAS unsigned short*)raw + lane;
#pragma unroll 1
    for (int o = o0; o < o1; ++o) {
        const LAS unsigned short* ro = rw + (8 * o) * 64;
        unsigned short xr[8], xk[8], xv[8], xl[8], xa[8];
#pragma unroll
        for (int e8 = 0; e8 < 8; ++e8) { xr[e8] = ro[(0 * 32 + e8) * 64]; xk[e8] = ro[(1 * 32 + e8) * 64]; xv[e8] = ro[(2 * 32 + e8) * 64]; xl[e8] = ro[(3 * 32 + e8) * 64]; xa[e8] = ro[(4 * 32 + e8) * 64]; }
        const f32x4 kn0 = *(const LAS f32x4*)(kns + 8 * o), kn1 = *(const LAS f32x4*)(kns + 8 * o + 4);
        __builtin_amdgcn_sched_barrier(0);
        unsigned pa[4][4];
        float ha[4] = {0.f, 0.f, 0.f, 0.f};
        LAS unsigned short* npo = (LAS unsigned short*)(nat + (8 * o) * NAT_LD) + lane;
#pragma unroll
        for (int e8 = 0; e8 < 8; ++e8) {
            const float r = h2f(xr[e8]), k = h2f(xk[e8]), v = h2f(xv[e8]), lw = h2f(xl[e8]), av = h2f(xa[e8]);
            const float Ep = E; E = E * __expf(lw); const float iE = __builtin_amdgcn_rcpf(E);
            const float kkn = k * kkc * (e8 < 4 ? kn0[e8 & 3] : kn1[e8 & 3]);
            const float kd = k * (1.0f + (av - 1.0f) * kac);
            const float bvec = kkn * av, at = -kkn * Ep, bh = bvec * iE, kh = kd * iE, rt = r * E;
            const unsigned w01 = pkbf(bh, kh), w23 = pkbf(at, rt);
            LAS unsigned short* np_ = npo + e8 * (NAT_LD / 2);
            np_[0] = (unsigned short)w01; np_[NAT_ARR / 2] = (unsigned short)(w01 >> 16); np_[2 * (NAT_ARR / 2)] = (unsigned short)w23; np_[3 * (NAT_ARR / 2)] = (unsigned short)(w23 >> 16);
            if ((e8 & 1) == 0) { ha[0] = at; ha[1] = v; ha[2] = bh; ha[3] = kh; }
            else { pa[0][e8 >> 1] = pkbf(ha[0], at); pa[1][e8 >> 1] = pkbf(ha[1], v); pa[2][e8 >> 1] = pkbf(ha[2], bh); pa[3][e8 >> 1] = pkbf(ha[3], kh); }
        }
#pragma unroll
        for (int ar = 0; ar < 4; ++ar) *(LAS u32x4*)(chm + ar * CHM_ARR + lane * CHM_LD + 16 * o) = (u32x4){pa[ar][0], pa[ar][1], pa[ar][2], pa[ar][3]};
    }
    return E;
}
DI void scan_decode(int unit, int& s, int& hh, int& d) { if (unit < 256) { s = unit >> 5; hh = (unit >> 1) & 15; d = unit & 1; } else { const int uu = unit - 256; s = 8 + (uu >> 5); hh = (uu >> 1) & 15; d = uu & 1; } }
template <int DB> DI void scan_helper(CArgs& a, LAS unsigned char* sm, int l, int unit, int lane, int hsel) {
    int s, hh, d; scan_decode(unit, s, hh, d);
    const int T = seq_len(s), mbase = seq_start(s), ch = hh * 64 + lane, nchunk = T >> 5;
    const unsigned short* i_r = (const unsigned short*)(a.ws + WS_QKV);
    const unsigned short* const src[5] = {i_r, i_r + PLANE, i_r + 2 * PLANE, (const unsigned short*)(a.ws + WS_HB) + (size_t)d * PLANE, (const unsigned short*)(a.ws + WS_EX) + (size_t)d * PLANE};
    const float* g_kn = (const float*)(a.ws + WS_KN) + hh; const float* g_bon = g_kn + (size_t)(1 + d) * TOK * 16;
    const float kkc = a.in[I_KK][l * 1024 + ch], kac = a.in[I_KA][l * 1024 + ch];
    asm volatile("" : "+s"(sm));
    LAS unsigned char* raw = sm + O_RAW;
    volatile LAS unsigned* flg = (volatile LAS unsigned*)(sm + SlotMap<DB>::O_FLAG);
    float knv = 0.f, bnv = 0.f;
    if (hsel == 0) { scan_dma(src, raw, (size_t)2 * hh * TOK + (size_t)(mbase + (d ? T - 32 : 0)), d, lane);
        const size_t o = (size_t)(mbase + (d ? T - 1 - (lane & 31) : (lane & 31))) * 16; knv = g_kn[o]; bnv = g_bon[o];
        asm volatile("s_waitcnt vmcnt(0)" ::: "memory"); }
#pragma unroll 1
    for (int n = 0; n < nchunk; ++n) {
        const int b = (DB == 2) ? (n & 1) : 0;
        LAS unsigned char* nat = sm + O_BUF + b * NC_BUF; LAS unsigned char* chm = nat + NAT_ALL;
        LAS float* ecv = (LAS float*)(sm + SlotMap<DB>::O_SM + b * 512); LAS float* bon = ecv + 64; LAS float* kns = ecv + 96;
        if (hsel == 0) {
            if (n + 1 > DB) spin_ge(flg + F_CONS, (unsigned)(n + 1 - DB));
            { int ln = lane; asm volatile("" : "+v"(ln)); if (ln < 32) { kns[ln] = knv; bon[ln] = bnv; } }
            asm volatile("s_waitcnt lgkmcnt(0)" ::: "memory");
            if (lane == 0) flg[F_RAW] = (unsigned)(n + 1);
            (void)scan_stage(raw, nat, chm, kns, lane, 0, 2, 1.0f, kkc, kac);
            asm volatile("s_waitcnt lgkmcnt(0)" ::: "memory");
            if (lane == 0) flg[F_ST0] = (unsigned)(n + 1);
            spin_ge(flg + F_ST1, (unsigned)(n + 1));
            if (n + 1 < nchunk) { scan_dma(src, raw, (size_t)2 * hh * TOK + (size_t)(mbase + (d ? T - 32 * (n + 2) : 32 * (n + 1))), d, lane);
                const size_t o = (size_t)(mbase + (d ? T - 32 * (n + 1) - 1 - (lane & 31) : 32 * (n + 1) + (lane & 31))) * 16; knv = g_kn[o]; bnv = g_bon[o];
                asm volatile("s_waitcnt vmcnt(0)" ::: "memory"); }
        } else {
            spin_ge(flg + F_RAW, (unsigned)(n + 1));
            const LAS unsigned short* rw = (const LAS unsigned short*)raw + lane;
            float lam = 0.f; unsigned short xl[16];
#pragma unroll
            for (int t = 0; t < 16; ++t) xl[t] = rw[(3 * 32 + t) * 64];
#pragma unroll
            for (int t = 0; t < 16; ++t) lam += h2f(xl[t]);
            const float E = scan_stage(raw, nat, chm, kns, lane, 2, 4, __expf(lam), kkc, kac);
            ecv[lane] = E;
            asm volatile("s_waitcnt lgkmcnt(0)" ::: "memory");
            if (lane == 0) flg[F_ST1] = (unsigned)(n + 1);
        }
    }
}
#define ZERO16(x) do { _Pragma("unroll") for (int _i = 0; _i < 16; ++_i) (x)[_i] = 0.f; } while (0)
template <int DB> DI void scan_unit(CArgs& a, LAS unsigned char* sm, int l, int unit, int lane) {
    int s, hh, d; scan_decode(unit, s, hh, d);
    const int T = seq_len(s), mbase = seq_start(s), nchunk = T >> 5;
    unsigned short* yout = (unsigned short*)(a.ws + WS_RBUF) + (size_t)d * PLANE;
    asm volatile("" : "+s"(sm));
    volatile LAS unsigned* flg = (volatile LAS unsigned*)(sm + SlotMap<DB>::O_FLAG);
    f32x16 ST[2][2];
#pragma unroll
    for (int x = 0; x < 2; ++x)
#pragma unroll
        for (int y = 0; y < 2; ++y) ZERO16(ST[x][y]);
#pragma unroll 1
    for (int c = 0; c < nchunk; ++c) {
        const int tok0 = d ? T - 32 * (c + 1) : 32 * c;
        const int b = (DB == 2) ? (c & 1) : 0;
        const LAS unsigned char* nat = sm + O_BUF + b * NC_BUF; const LAS unsigned char* chm = nat + NAT_ALL;
        const LAS float* ecv = (const LAS float*)(sm + SlotMap<DB>::O_SM + b * 512); const LAS float* bon = ecv + 64;
        spin_ge(flg + F_ST0, (unsigned)(c + 1)); spin_ge(flg + F_ST1, (unsigned)(c + 1));
        int lq = lane; asm volatile("" : "+v"(lq)); const int rq = lq & 31, h = lq >> 5;
        const LAS unsigned char* natr = nat + rq * NAT_LD + 16 * h;
#define NATF(arr, ks) (*(const LAS bf16x8*)(natr + (arr) * NAT_ARR + 32 * (ks)))
#define CHMROW(arr, blk) (chm + (arr) * CHM_ARR + (32 * (blk) + rq) * CHM_LD)
#define CHMF(arr, blk, ks) (*(const LAS bf16x8*)(CHMROW(arr, blk) + 32 * (ks) + 16 * h))
        f32x16 Tm, UakT, Wrb, Wrk;
        ZERO16(UakT); ZERO16(Wrb); ZERO16(Wrk);
        {
            f32x16 Nm, NT, TT;
            ZERO16(Nm); ZERO16(NT);
#pragma unroll
            for (int ks = 0; ks < 4; ++ks) { const bf16x8 fb = NATF(0, ks), fa = NATF(2, ks); Nm = MFMA32(fb, fa, Nm); NT = MFMA32(fa, fb, NT); }
#pragma unroll
            for (int i = 0; i < 16; ++i) { const int row = (i & 3) + 8 * (i >> 2) + 4 * h; Nm[i] = row < rq ? Nm[i] : 0.f; NT[i] = rq < row ? NT[i] : 0.f; Tm[i] = Nm[i] + (row == rq ? 1.f : 0.f); TT[i] = NT[i] + (row == rq ? 1.f : 0.f); }
#pragma unroll
            for (int st = 0; st < 4; ++st) {
                const bf16x8 pN0 = packc(Nm, 0), pN1 = packc(Nm, 1), pT0 = packc(NT, 0), pT1 = packc(NT, 1);
                f32x16 N2; ZERO16(N2); N2 = MFMA32(pT0, pN0, N2); N2 = MFMA32(pT1, pN1, N2);
                f32x16 N2T; ZERO16(N2T);
                if (st < 3) { N2T = MFMA32(pN0, pT0, N2T); N2T = MFMA32(pN1, pT1, N2T); }
                { const bf16x8 fb = NATF(0, st), fk = NATF(1, st), fa = NATF(2, st), fr = NATF(3, st);
                  UakT = MFMA32(fa, fk, UakT); Wrb = MFMA32(fb, fr, Wrb); Wrk = MFMA32(fk, fr, Wrk); }
                const bf16x8 pM0 = packc(N2, 0), pM1 = packc(N2, 1), pU0 = packc(TT, 0), pU1 = packc(TT, 1);
                Tm = MFMA32(pU0, pM0, Tm); Tm = MFMA32(pU1, pM1, Tm);
                if (st < 3) { TT = MFMA32(pM0, pU0, TT); TT = MFMA32(pM1, pU1, TT); Nm = N2; NT = N2T; }
            }
        }
        f32x16 Z[2];
        {   f32x16 X, P[2];
            const float bnc = bon[rq];
#pragma unroll
            for (int i = 0; i < 16; ++i) { const int row = (i & 3) + 8 * (i >> 2) + 4 * h; UakT[i] = rq < row ? UakT[i] : 0.f; Wrb[i] = row <= rq ? Wrb[i] : 0.f; Wrk[i] = row <= rq ? Wrk[i] : 0.f; if (row == rq) Wrk[i] += bnc; }
            const bf16x8 pT0 = packc(Tm, 0), pT1 = packc(Tm, 1);
            ZERO16(X); X = MFMA32(packc(UakT, 0), pT0, X); X = MFMA32(packc(UakT, 1), pT1, X);
            const bf16x8 pX0 = packc(X, 0), pX1 = packc(X, 1);
#pragma unroll
            for (int b2 = 0; b2 < 2; ++b2) { ZERO16(P[b2]); ZERO16(Z[b2]);
                P[b2] = MFMA32(ld_perm(CHMROW(0, b2), 0, h), pT0, P[b2]); P[b2] = MFMA32(ld_perm(CHMROW(0, b2), 1, h), pT1, P[b2]);
                Z[b2] = MFMA32(pX0, ld_perm(CHMROW(1, b2), 0, h), Z[b2]); Z[b2] = MFMA32(pX1, ld_perm(CHMROW(1, b2), 1, h), Z[b2]); }
#pragma unroll
            for (int jb = 0; jb < 2; ++jb) { const bf16x8 p0 = packc(P[jb], 0), p1 = packc(P[jb], 1);
#pragma unroll
                for (int ib = 0; ib < 2; ++ib) { Z[ib] = MFMA32(p0, packc(ST[jb][ib], 0), Z[ib]); Z[ib] = MFMA32(p1, packc(ST[jb][ib], 1), Z[ib]); } }
        }
        {   f32x16 Y[2];
            const bf16x8 pK0 = packc(Wrk, 0), pK1 = packc(Wrk, 1), pW0 = packc(Wrb, 0), pW1 = packc(Wrb, 1);
            const LAS unsigned char* rrow = nat + 3 * NAT_ARR + rq * NAT_LD;
#pragma unroll
            for (int ib = 0; ib < 2; ++ib) { ZERO16(Y[ib]);
                Y[ib] = MFMA32(pK0, ld_perm(CHMROW(1, ib), 0, h), Y[ib]); Y[ib] = MFMA32(pK1, ld_perm(CHMROW(1, ib), 1, h), Y[ib]);
                Y[ib] = MFMA32(pW0, packc(Z[ib], 0), Y[ib]); Y[ib] = MFMA32(pW1, packc(Z[ib], 1), Y[ib]);
#pragma unroll
                for (int jb = 0; jb < 2; ++jb) { Y[ib] = MFMA32(ld_perm(rrow + 64 * jb, 0, h), packc(ST[jb][ib], 0), Y[ib]); Y[ib] = MFMA32(ld_perm(rrow + 64 * jb, 1, h), packc(ST[jb][ib], 1), Y[ib]); } }
#pragma unroll
            for (int ib = 0; ib < 2; ++ib)
#pragma unroll
                for (int i = 0; i < 16; ++i) { const int tau = (i & 3) + 8 * (i >> 2) + 4 * h; const int tok = tok0 + (d ? 31 - tau : tau);
                    yout[(size_t)(mbase + tok) * 1024 + hh * 64 + 32 * ib + rq] = (unsigned short)pkbf(Y[ib][i], 0.f); }
        }
        {
#pragma unroll
            for (int ib = 0; ib < 2; ++ib) { const bf16x8 pZ0 = packc(Z[ib], 0), pZ1 = packc(Z[ib], 1);
#pragma unroll
                for (int jc = 0; jc < 2; ++jc) {
                    ST[jc][ib] = MFMA32(ld_perm(CHMROW(2, jc), 0, h), pZ0, ST[jc][ib]); ST[jc][ib] = MFMA32(ld_perm(CHMROW(2, jc), 1, h), pZ1, ST[jc][ib]);
                    ST[jc][ib] = MFMA32(CHMF(3, jc, 0), CHMF(1, ib, 0), ST[jc][ib]); ST[jc][ib] = MFMA32(CHMF(3, jc, 1), CHMF(1, ib, 1), ST[jc][ib]); } }
#pragma unroll
            for (int jc = 0; jc < 2; ++jc)
#pragma unroll
                for (int g4 = 0; g4 < 4; ++g4) { const f32x4 e = *(const LAS f32x4*)(ecv + 32 * jc + 8 * g4 + 4 * h);
#pragma unroll
                    for (int ib = 0; ib < 2; ++ib) { ST[jc][ib][4 * g4 + 0] *= e.x; ST[jc][ib][4 * g4 + 1] *= e.y; ST[jc][ib][4 * g4 + 2] *= e.z; ST[jc][ib][4 * g4 + 3] *= e.w; } }
        }
#undef NATF
#undef CHMROW
#undef CHMF
        asm volatile("s_waitcnt lgkmcnt(0)" ::: "memory");
        if (lane == 0) flg[F_CONS] = (unsigned)(c + 1);
    }
}
DI void phase_scan(CArgs& a, LAS unsigned char* lds, int l, int lane, int wave, int G) {
    LAS unsigned char* sm1 = lds + SLOT0;
    if (wave == 0 && lane < 16) ((LAS unsigned*)(lds + SlotMap<2>::O_FLAG))[lane] = 0u;
    if (wave == 1 && lane < 16) ((LAS unsigned*)(sm1 + SlotMap<1>::O_FLAG))[lane] = 0u;
    __syncthreads();
    const bool has1 = blockIdx.x < 128;
    const int nbg = G + (G - 128) * 3;
    if (wave == 0) { __builtin_amdgcn_s_setprio(3); scan_unit<2>(a, lds, l, blockIdx.x, lane); __builtin_amdgcn_s_setprio(0); }
    else if (wave == 2) { __builtin_amdgcn_s_setprio(3); scan_helper<2>(a, lds, l, blockIdx.x, lane, 0); __builtin_amdgcn_s_setprio(0); }
    else if (wave == 3) { __builtin_amdgcn_s_setprio(3); scan_helper<2>(a, lds, l, blockIdx.x, lane, 1); __builtin_amdgcn_s_setprio(0); }
    else if (wave == 4) { }
    else if (wave == 5) background_weights(a, l, (LAS float*)(lds + SLOT0 + SLOT1), blockIdx.x, nbg, lane);
    else if (has1) { if (wave == 1) scan_unit<1>(a, sm1, l, 256 + blockIdx.x, lane); else if (wave == 6) scan_helper<1>(a, sm1, l, 256 + blockIdx.x, lane, 0); else scan_helper<1>(a, sm1, l, 256 + blockIdx.x, lane, 1); }
    else { const int q = wave == 1 ? 0 : wave == 6 ? 1 : 2; background_weights(a, l, (LAS float*)(sm1 + q * 4224), G + (blockIdx.x - 128) * 3 + q, nbg, lane); }
}


DI void phase_post(CArgs& a, int l, int lane, int wave, int G) {
    const unsigned short* y0 = (const unsigned short*)(a.ws + WS_RBUF); const unsigned short* y1 = y0 + PLANE;
    unsigned short* mx = (unsigned short*)(a.ws + WS_MIXIN);
    const unsigned short* gbuf = (const unsigned short*)(a.ws + WS_G) + (size_t)(lane >> 3) * TOK * 32 + 4 * (lane & 7);
    const float* ssq = (const float*)(a.ws + WS_SSQ);
    f32x4 lnw[4], lnb[4];
#pragma unroll
    for (int j = 0; j < 4; ++j) { const int c = 4 * (lane + 64 * j); lnw[j] = *(const f32x4*)(a.in[I_LNW] + l * 1024 + c); lnb[j] = *(const f32x4*)(a.in[I_LNB] + l * 1024 + c); }
    u32x2 ny0[4], ny1[4]; f32x4 ns0, ns1; u32x2 ng[4];
#define POST_LOAD(mm_) do { _Pragma("unroll") for (int j = 0; j < 4; ++j) { ny0[j] = __builtin_nontemporal_load((const u32x2*)(y0 + (size_t)(mm_) * 1024) + lane + 64 * j); ny1[j] = __builtin_nontemporal_load((const u32x2*)(y1 + (size_t)(mm_) * 1024) + lane + 64 * j); \
            ng[j] = __builtin_nontemporal_load((const u32x2*)(gbuf + ((size_t)8 * j * TOK + (mm_)) * 32)); } \
            ns0 = *(const f32x4*)(ssq + (size_t)(mm_) * 8); ns1 = *(const f32x4*)(ssq + (size_t)(mm_) * 8 + 4); } while (0)
    int m = blockIdx.x * 8 + wave;
    if (m < TOK) POST_LOAD(m);
#pragma unroll 1
    for (; m < TOK; m += G * 8) {
        f32x4 y[4]; u32x2 g[4]; const f32x4 s0 = ns0, s1 = ns1;
#pragma unroll
        for (int j = 0; j < 4; ++j) { y[j] = (f32x4){bflo(ny0[j].x) + bflo(ny1[j].x), bfhi(ny0[j].x) + bfhi(ny1[j].x), bflo(ny0[j].y) + bflo(ny1[j].y), bfhi(ny0[j].y) + bfhi(ny1[j].y)}; g[j] = ng[j]; }
        if (m + G * 8 < TOK) POST_LOAD(m + G * 8);
        const float irs = __builtin_sqrtf(((s0.x + s0.y) + (s0.z + s0.w) + (s1.x + s1.y) + (s1.z + s1.w)) * (1.0f / 1024.0f) + NORM_EPS);
#pragma unroll
        for (int j = 0; j < 4; ++j) {
            float sum = (y[j].x + y[j].y) + (y[j].z + y[j].w);
            sum = DPP_ROR_ADD(sum, 8); sum = DPP_ROR_ADD(sum, 4); sum = DPP_ROR_ADD(sum, 2); sum = DPP_ROR_ADD(sum, 1);
            const float mean = sum * (1.0f / 64.0f);
            const f32x4 dv = y[j] - mean;
            float sq = (dv.x * dv.x + dv.y * dv.y) + (dv.z * dv.z + dv.w * dv.w);
            sq = DPP_ROR_ADD(sq, 8); sq = DPP_ROR_ADD(sq, 4); sq = DPP_ROR_ADD(sq, 2); sq = DPP_ROR_ADD(sq, 1);
            const float rstd = __builtin_amdgcn_rsqf(sq * (1.0f / 64.0f) + GN_EPS);
            const f32x4 o = (dv * rstd * lnw[j] + lnb[j]) * ((f32x4){hlo(g[j].x), hhi(g[j].x), hlo(g[j].y), hhi(g[j].y)} * irs);
            u32x2 w; w.x = pk2(o.x, o.y); w.y = pk2(o.z, o.w);
            ((u32x2*)(mx + (size_t)m * D + 1024))[lane + 64 * j] = w; }
    }
#undef POST_LOAD
}
constexpr int NPHASE = 2 + 10 * DEPTH;
__global__ void __launch_bounds__(512, 2) hymba_fwd(Args args) {
    extern __shared__ __attribute__((aligned(16))) unsigned char lds_raw[];
    LAS unsigned char* lds = (LAS unsigned char*)lds_raw;
    const int G = gridDim.x;
    const int wave_sgpr = __builtin_amdgcn_readfirstlane(threadIdx.x >> 6);
    if (threadIdx.x < 64) ((LAS unsigned*)(lds + L_MISC))[threadIdx.x] = 0u;
    __syncthreads();
    const int lo = args.ph_lo, hi = args.ph_hi;
    XcdBarrier bar; bar.bar = (unsigned*)(args.ws + WS_CTL) + CW_BAR; bar.x = 0; bar.st = nullptr;
    if (hi - lo > 1) bar = xcd_barrier_post((unsigned*)(args.ws + WS_CTL) + CW_BAR, (volatile LAS unsigned*)(lds + L_MISC));
#define PH(k) (lo <= (k) && (k) < hi)
#define LANE_IDS CArgs* ap_ = (CArgs*)__builtin_amdgcn_kernarg_segment_ptr(); asm volatile("" : "+s"(ap_)); CArgs& A = *ap_; unsigned z_; asm volatile("v_mov_b32 %0, 0" : "=v"(z_)); const int tid = wave_sgpr * 64 + (int)__builtin_amdgcn_mbcnt_hi(~0u, __builtin_amdgcn_mbcnt_lo(~0u, z_)); const int lane = tid & 63, wave = __builtin_amdgcn_readfirstlane(tid >> 6); (void)lane; (void)wave
#define SEAM(k) do { if (PH(k) && PH((k) + 1)) { xcd_barrier(bar); if (MK_PROBE_REP == 100) xcd_barrier(bar); } } while (0)
#ifndef MK_PROBE_REP
#define MK_PROBE_REP -1
#endif
#define NREP(k) ((MK_PROBE_REP == (k)) ? 2 : 1)
    if (PH(0)) { LANE_IDS; phase_prologue(A, lds, tid, lane, wave, G); }
#if MK_PROBE_REP == 101
    xcd_barrier(bar); if (PH(0)) { LANE_IDS; phase_prologue(A, lds, tid, lane, wave, G); }
#endif
    SEAM(0);
#if MK_PROBE_REP == 103
    if (PH(1)) { LANE_IDS; const f32x4* src_ = (const f32x4*)A.in[I_XP]; f32x4* dst_ = (f32x4*)(A.ws + WS_HID);
        for (int m = blockIdx.x * 8 + wave; m < 32768; m += G * 8) { f32x4 v_[8];
#pragma unroll
            for (int j = 0; j < 8; ++j) v_[j] = __builtin_nontemporal_load(src_ + (size_t)m * 512 + lane + 64 * j);
#pragma unroll
            for (int j = 0; j < 8; ++j) __builtin_nontemporal_store(v_[j], dst_ + (size_t)m * 512 + lane + 64 * j); } }
    if (PH(1)) xcd_barrier(bar);
#endif
    if (PH(1)) { LANE_IDS; phase_resnorm(A, lds, 0, 0, tid, lane, wave, G); }
#if MK_PROBE_REP == 102
    xcd_barrier(bar); if (PH(1)) { LANE_IDS; phase_resnorm(A, lds, 0, 0, tid, lane, wave, G); }
#endif
    SEAM(1);
#pragma unroll 1
    for (int l = 0; l < DEPTH; ++l) {
        const int b = 2 + 10 * l;
        if (PH(b + 0)) { LANE_IDS;
            pg8::Gemm g{(const pg8::bf16_t*)(A.ws + WS_HB), (const pg8::bf16_t*)(A.ws + WS_WIN) + (size_t)(l & 1) * NIN * D, TOK, l == 0 ? NIN - 256 : NIN, D}; pg8::StaticOrder S; S.init(TOK, l == 0 ? NIN - 256 : NIN, G, (int)blockIdx.x);
            pg8::EpiOut<0> E{(pg8::bf16_t*)(A.ws + WS_QKV), NQKV, (pg8::bf16_t*)(A.ws + WS_LORA), NLB, NQKV / 256, (pg8::bf16_t*)(A.ws + WS_RBUF), 12, TOK};
            pg8::gemm_phase<pg8::EpiOut<0>, pg8::StaticOrder, true, true>(lds + L_RING, g, S, E, tid);
        }
#if MK_PROBE_REP == 0
        xcd_barrier(bar);
        if (PH(b + 0)) { LANE_IDS;
            pg8::Gemm g{(const pg8::bf16_t*)(A.ws + WS_HB), (const pg8::bf16_t*)(A.ws + WS_WIN) + (size_t)(l & 1) * NIN * D, TOK, l == 0 ? NIN - 256 : NIN, D}; pg8::StaticOrder S; S.init(TOK, l == 0 ? NIN - 256 : NIN, G, (int)blockIdx.x);
            pg8::EpiOut<0> E{(pg8::bf16_t*)(A.ws + WS_QKV), NQKV, (pg8::bf16_t*)(A.ws + WS_LORA), NLB, NQKV / 256, (pg8::bf16_t*)(A.ws + WS_RBUF), 12, TOK};
            pg8::gemm_phase<pg8::EpiOut<0>, pg8::StaticOrder, true, true>(lds + L_RING, g, S, E, tid);
        }
#endif
        SEAM(b + 0);
        if (PH(b + 1)) { LANE_IDS; phase_attention(A, lds, l, tid, lane, wave, G); }
#if MK_PROBE_REP == 1
        xcd_barrier(bar); if (PH(b + 1)) { LANE_IDS; phase_attention(A, lds, l, tid, lane, wave, G); }
#endif
        SEAM(b + 1);
        if (PH(b + 2)) { LANE_IDS; phase_prep(A, lds, l, tid, lane, wave, G); }
#if MK_PROBE_REP == 2
        xcd_barrier(bar); if (PH(b + 2)) { LANE_IDS; phase_prep(A, lds, l, tid, lane, wave, G); }
#endif
        SEAM(b + 2);
        if (PH(b + 3)) { LANE_IDS; phase_scan(A, lds, l, lane, wave, G); }
#if MK_PROBE_REP == 3
        xcd_barrier(bar); if (PH(b + 3)) { LANE_IDS; phase_scan(A, lds, l, lane, wave, G); }
#endif
        SEAM(b + 3);
        if (PH(b + 4)) { LANE_IDS; phase_post(A, l, lane, wave, G); }
        SEAM(b + 4);
        if (PH(b + 5)) { LANE_IDS;
            pg8::Gemm g{(const pg8::bf16_t*)(A.ws + WS_MIXIN), (const pg8::bf16_t*)(A.ws + WS_WOUT) + (size_t)(l & 1) * D * D, TOK, D, D}; pg8::StaticOrder S; S.init(TOK, D, G, (int)blockIdx.x);
            pg8::EpiOut<0> E{(pg8::bf16_t*)(A.ws + WS_RBUF), D, nullptr, 0, 1 << 30, nullptr, 0, 0};
            pg8::gemm_phase<pg8::EpiOut<0>, pg8::StaticOrder, true, true>(lds + L_RING, g, S, E, tid);
        }
#if MK_PROBE_REP == 5
        xcd_barrier(bar);
        if (PH(b + 5)) { LANE_IDS;
            pg8::Gemm g{(const pg8::bf16_t*)(A.ws + WS_MIXIN), (const pg8::bf16_t*)(A.ws + WS_WOUT) + (size_t)(l & 1) * D * D, TOK, D, D}; pg8::StaticOrder S; S.init(TOK, D, G, (int)blockIdx.x);
            pg8::EpiOut<0> E{(pg8::bf16_t*)(A.ws + WS_RBUF), D, nullptr, 0, 1 << 30, nullptr, 0, 0};
            pg8::gemm_phase<pg8::EpiOut<0>, pg8::StaticOrder, true, true>(lds + L_RING, g, S, E, tid);
        }
#endif
        SEAM(b + 5);
        if (PH(b + 6)) { LANE_IDS; phase_resnorm(A, lds, l, 1, tid, lane, wave, G); }
        SEAM(b + 6);
        if (PH(b + 7)) { LANE_IDS;
            pg8::Gemm g{(const pg8::bf16_t*)(A.ws + WS_HB), (const pg8::bf16_t*)(A.ws + WS_WF1), TOK, DFF, D}; pg8::StaticOrder S; S.init(TOK, DFF, G, (int)blockIdx.x);
            pg8::EpiOut<1> E{(pg8::bf16_t*)(A.ws + WS_HID), DFF, nullptr, 0, 1 << 30, nullptr, 0, 0};
            pg8::gemm_phase<pg8::EpiOut<1>, pg8::StaticOrder, true, true>(lds + L_RING, g, S, E, tid);
        }
#if MK_PROBE_REP == 7
        xcd_barrier(bar);
        if (PH(b + 7)) { LANE_IDS;
            pg8::Gemm g{(const pg8::bf16_t*)(A.ws + WS_HB), (const pg8::bf16_t*)(A.ws + WS_WF1), TOK, DFF, D}; pg8::StaticOrder S; S.init(TOK, DFF, G, (int)blockIdx.x);
            pg8::EpiOut<1> E{(pg8::bf16_t*)(A.ws + WS_HID), DFF, nullptr, 0, 1 << 30, nullptr, 0, 0};
            pg8::gemm_phase<pg8::EpiOut<1>, pg8::StaticOrder, true, true>(lds + L_RING, g, S, E, tid);
        }
#endif
        SEAM(b + 7);
        if (PH(b + 8)) { LANE_IDS;
            pg8::Gemm g{(const pg8::bf16_t*)(A.ws + WS_HID), (const pg8::bf16_t*)(A.ws + WS_WF2), TOK, D, DFF}; pg8::StaticOrder S; S.init(TOK, D, G, (int)blockIdx.x);
            pg8::EpiOut<0> E{(pg8::bf16_t*)(A.ws + WS_EX), D, nullptr, 0, 1 << 30, nullptr, 0, 0};
            pg8::gemm_phase<pg8::EpiOut<0>, pg8::StaticOrder, true, true>(lds + L_RING, g, S, E, tid);
        }
#if MK_PROBE_REP == 8
        xcd_barrier(bar);
        if (PH(b + 8)) { LANE_IDS;
            pg8::Gemm g{(const pg8::bf16_t*)(A.ws + WS_HID), (const pg8::bf16_t*)(A.ws + WS_WF2), TOK, D, DFF}; pg8::StaticOrder S; S.init(TOK, D, G, (int)blockIdx.x);
            pg8::EpiOut<0> E{(pg8::bf16_t*)(A.ws + WS_EX), D, nullptr, 0, 1 << 30, nullptr, 0, 0};
            pg8::gemm_phase<pg8::EpiOut<0>, pg8::StaticOrder, true, true>(lds + L_RING, g, S, E, tid);
        }
#endif
        SEAM(b + 8);
        if (PH(b + 9)) { LANE_IDS; phase_resnorm(A, lds, l, 2, tid, lane, wave, G); }
        SEAM(b + 9);
    }
#undef PH
#undef SEAM
}

extern "C" void kernel_launch(void* const* d_in, const int* in_sizes, int n_in, void* d_out, int out_size, void* d_ws, size_t ws_size, hipStream_t stream) {
    static int grid = 0;
    if (grid == 0) {
        if (n_in != 35 || out_size != TOK * D || ws_size < WS_END) { fprintf(stderr, "kernel_launch: unexpected problem (n_in %d, out %d, ws %zu); nothing launched\n", n_in, out_size, ws_size); grid = -1; return; }
        int dev = 0, cus = 0, per_cu = 0;
        if (hipGetDevice(&dev) != hipSuccess || hipDeviceGetAttribute(&cus, hipDeviceAttributeMultiprocessorCount, dev) != hipSuccess) { grid = -1; return; }
        if (hipFuncSetAttribute((const void*)hymba_fwd, hipFuncAttributeMaxDynamicSharedMemorySize, LDS_BYTES) != hipSuccess) { fprintf(stderr, "kernel_launch: hipFuncSetAttribute failed\n"); grid = -1; return; }
        if (hipOccupancyMaxActiveBlocksPerMultiprocessor(&per_cu, (const void*)hymba_fwd, 512, LDS_BYTES) != hipSuccess || per_cu < 1) { fprintf(stderr, "kernel_launch: occupancy query says %d blocks per CU\n", per_cu); (void)hipGetLastError(); grid = -1; return; }
        grid = cus;
    }
    if (grid < 0) return;
    (void)hipMemsetAsync((char*)d_ws + WS_CTL, 0, CTL_ZERO_BYTES, stream);
    Args a{};
    for (int i = 0; i < 35; ++i) a.in[i] = (const float*)d_in[i];
    a.out = (float*)d_out; a.ws = (unsigned char*)d_ws;
#if MK_LAUNCH_PER_PHASE
    for (int p = 0; p < NPHASE; ++p) { a.ph_lo = p; a.ph_hi = p + 1; hipLaunchKernelGGL(hymba_fwd, dim3(grid), dim3(512), LDS_BYTES, stream, a); }
#else
    a.ph_lo = 0; a.ph_hi = NPHASE; hipLaunchKernelGGL(hymba_fwd, dim3(grid), dim3(512), LDS_BYTES, stream, a);
#endif
    const hipError_t le = hipPeekAtLastError();
    if (le != hipSuccess) fprintf(stderr, "kernel_launch: launch failed: %s\n", hipGetErrorName(le));
}
```

```cpp
#include <hip/hip_runtime.h>
#include <cstdio>
#include <cstdint>

#ifndef MK_LAUNCH_PER_PHASE
#define MK_LAUNCH_PER_PHASE 0
#define MK_PROBE_REP -1
#define MK_PREP_PROBE 0
#endif
namespace pg8 {
#define PG8_LAS __attribute__((address_space(3)))
typedef unsigned short bf16_t;
typedef short bf16x8 __attribute__((ext_vector_type(8)));
typedef float f32x4 __attribute__((ext_vector_type(4)));
typedef unsigned u32x4 __attribute__((ext_vector_type(4)));
constexpr int BM = 256, BK = 64, HALF = 128, HTB = HALF * BK * 2  , STAGE_BYTES = 8 * HTB, NXCD = 8, WGM = 4;

__host__ __device__ __forceinline__ int lds_byte(int r, int c) { const int st = (r >> 4) * 2 + (c >> 5), rr = r & 15, cc = c & 31, ob = rr * 64 + cc * 2; return st * 1024 + (ob ^ (((ob >> 9) & 1) << 5)); }
__host__ __device__ __forceinline__ void stage_rc(int b, int& R, int& C) { const int st = b / 1024, sb = b % 1024, swz = sb ^ (((sb >> 9) & 1) << 5); R = (st >> 1) * 16 + swz / 64; C = (st & 1) * 32 + (swz % 64) / 2; }
__host__ __device__ __forceinline__ int perm32(int rho) { const int n = rho >> 4, i = rho & 15; return 8 * (i >> 2) + 4 * n + (i & 3); }

struct Unit { int pm, pn; };
struct Gemm { const bf16_t* A; const bf16_t* Bt; int M, N, K; };

struct StaticOrder {
    int nM, nN, nwg, G, c;
    __host__ __device__ void init(int M, int N, int G_, int c_) { nM = M / BM; nN = N / BM; nwg = nM * nN; G = G_; c = c_; }
    __host__ __device__ bool next(int i, Unit& u) const {
        const long L = (long)i * G + c; if (L >= nwg) return false;
        int wgid = (int)L; { const int q = nwg / NXCD, r = nwg % NXCD, xcd = wgid % NXCD, off = wgid / NXCD; wgid = (xcd < r ? xcd * (q + 1) : r * (q + 1) + (xcd - r) * q) + off; }
        const int nig = WGM * nN, gid = wgid / nig, fm = gid * WGM, gsz = (nM - fm) < WGM ? (nM - fm) : WGM;
        u.pm = fm + ((wgid % nig) % gsz); u.pn = (wgid % nig) / gsz; return true;
    }
    __device__ __forceinline__ void a_ready(const Unit&) const {}
    __device__ __forceinline__ void done(const Unit&) const {}
};
__device__ __forceinline__ unsigned cvt_pk_bf16(float lo, float hi) { unsigned r; asm volatile("v_cvt_pk_bf16_f32 %0, %1, %2" : "=v"(r) : "v"(lo), "v"(hi)); return r; }
template <int ACT> struct EpiOut {
    static constexpr bool PERM = true, AFTER_DRAIN = false;
    bf16_t* O0; int ld0; bf16_t* O1; int ld1; int split_tile; bf16_t* CG; int cg_tiles; int cg_rows;
    __device__ __forceinline__ void operator()(const f32x4 (&acc)[2][2][4][2], const Unit& u, int wr, int wc, int fr, int fq) const {
        const int row0 = u.pm * BM + wr * 64 + fr;
        bf16_t* base; size_t rstride, bjstep;
        if (u.pn < split_tile) { base = O0 + (size_t)u.pn * BM + wc * 32 + 8 * fq; rstride = (size_t)ld0; bjstep = HALF; }
        else if (u.pn < split_tile + cg_tiles) { base = CG + (size_t)((u.pn - split_tile) * 8 + wc) * cg_rows * 32 + 8 * fq; rstride = 32; bjstep = (size_t)4 * cg_rows * 32; }
        else { base = O1 + (size_t)(u.pn - split_tile - cg_tiles) * BM + wc * 32 + 8 * fq; rstride = (size_t)ld1; bjstep = HALF; }
#pragma unroll
        for (int ai = 0; ai < 2; ++ai)
#pragma unroll
            for (int m = 0; m < 4; ++m) { bf16_t* rowp = base + (size_t)(row0 + ai * HALF + m * 16) * rstride;
#pragma unroll
                for (int bj = 0; bj < 2; ++bj) { f32x4 v0 = acc[ai][bj][m][0], v1 = acc[ai][bj][m][1];
                    if (ACT == 1) {
#pragma unroll
                        for (int j = 0; j < 4; ++j) { const float a = v0[j] > 0.f ? v0[j] : 0.f, b = v1[j] > 0.f ? v1[j] : 0.f; v0[j] = a * a; v1[j] = b * b; } }
                    u32x4 w; w.x = cvt_pk_bf16(v0[0], v0[1]); w.y = cvt_pk_bf16(v0[2], v0[3]); w.z = cvt_pk_bf16(v1[0], v1[1]); w.w = cvt_pk_bf16(v1[2], v1[3]);
                    if (ACT == 1) __builtin_nontemporal_store(w, (u32x4*)(rowp + bj * bjstep)); else *(u32x4*)(rowp + bj * bjstep) = w;
#if defined(MK_PREP_PROBE) && MK_PREP_PROBE == 6
                    if (ACT == 1) { asm volatile("" ::: "memory"); *(u32x4*)(rowp + bj * bjstep) = w; }
#endif
                    } }
    }
};

template <class Epi, class Sched, bool ALIGN_EPI = false, bool SP2 = false>
__device__ __forceinline__ void gemm_phase(PG8_LAS unsigned char* lds, const Gemm g, const Sched& S, const Epi& E, const int tid) {
    const int wid = __builtin_amdgcn_readfirstlane(tid >> 6), lane = tid & 63, wr = wid >> 2, wc = wid & 3, fr = lane & 15, fq = lane >> 4;
    const int K = g.K, nt = K / BK;
    unsigned voffA[2], voffB[2];
#pragma unroll
    for (int i = 0; i < 2; ++i) { int R, C; stage_rc(tid * 16 + i * 8192, R, C); const int Rb = Epi::PERM ? ((R & ~31) + perm32(R & 31)) : R;
        voffA[i] = (unsigned)(R * K + C) * 2u; voffB[i] = (unsigned)(Rb * K + C) * 2u; }
    const size_t kstep = (size_t)(BK * 2);
    const size_t hstep = (size_t)HALF * K * 2;
    const size_t tstep = 2 * hstep;
    const unsigned ldsw = (unsigned)wid * 1024u;
    const int aoff = lds_byte(wr * 64 + fr, fq * 8), boff = lds_byte(wc * 32 + fr, fq * 8);
#define PG8_SA(b, h) (((b) * 2 + (h)) * HTB)
#define PG8_SB(b, h) ((4 + (b) * 2 + (h)) * HTB)
#define PG8_STAGE(bufoff, gbase, voff) do { _Pragma("unroll") for (int _i = 0; _i < 2; ++_i) \
        __builtin_amdgcn_global_load_lds((const unsigned*)((const char*)(gbase) + (voff)[_i]), (PG8_LAS unsigned*)(lds + (bufoff) + ldsw + _i * 8192), 16, 0, 0); } while (0)
#define PG8_LDA(dst, b, h) do { _Pragma("unroll") for (int m = 0; m < 4; ++m) _Pragma("unroll") for (int k = 0; k < 2; ++k) dst[m][k] = *(const PG8_LAS bf16x8*)(lds + PG8_SA(b, h) + aoff + m * 2048 + k * 1024); } while (0)
#define PG8_LDB(dst, b, h) do { _Pragma("unroll") for (int n = 0; n < 2; ++n) _Pragma("unroll") for (int k = 0; k < 2; ++k) dst[n][k] = *(const PG8_LAS bf16x8*)(lds + PG8_SB(b, h) + boff + n * 2048 + k * 1024); } while (0)
#define PG8_MMA(ai, bj, At, Bt) do { __builtin_amdgcn_s_setprio(1); _Pragma("unroll") for (int m = 0; m < 4; ++m) _Pragma("unroll") for (int n = 0; n < 2; ++n) _Pragma("unroll") for (int k = 0; k < 2; ++k) \
        acc[ai][bj][m][n] = __builtin_amdgcn_mfma_f32_16x16x32_bf16(Bt[n][k], At[m][k], acc[ai][bj][m][n], 0, 0, 0); __builtin_amdgcn_s_setprio(0); } while (0)
#define PG8_WAIT_V(n) asm volatile("s_waitcnt vmcnt(" #n ")" ::: "memory")
#define PG8_WAIT_L(n) asm volatile("s_waitcnt lgkmcnt(" #n ")" ::: "memory")
#define PG8_BAR __builtin_amdgcn_s_barrier()
#define PG8_SCHED __builtin_amdgcn_sched_barrier(0)
    Unit cur, nxt; int ui = 0;
    if (!S.next(0, cur)) return;
    f32x4 acc[2][2][4][2];
#pragma unroll
    for (int a = 0; a < 2; ++a)
#pragma unroll
        for (int b = 0; b < 2; ++b)
#pragma unroll
            for (int m = 0; m < 4; ++m)
#pragma unroll
                for (int n = 0; n < 2; ++n) acc[a][b][m][n] = (f32x4){0.f, 0.f, 0.f, 0.f};
    bf16x8 At[4][2], B0[2][2], B1[2][2];
    const char* cA = (const char*)g.A + (size_t)cur.pm * tstep; const char* cB = (const char*)g.Bt + (size_t)cur.pn * tstep;
    S.a_ready(cur);
    if constexpr (SP2) {
        PG8_STAGE(PG8_SB(0, 0), cB, voffB); PG8_STAGE(PG8_SB(0, 1), cB + hstep, voffB); PG8_STAGE(PG8_SA(0, 0), cA, voffA); PG8_STAGE(PG8_SA(0, 1), cA + hstep, voffA);
        if (wr == 1) PG8_BAR;
        PG8_WAIT_V(2); PG8_BAR;
        PG8_STAGE(PG8_SB(1, 0), cB + kstep, voffB); PG8_STAGE(PG8_SA(1, 0), cA + kstep, voffA); PG8_STAGE(PG8_SB(1, 1), cB + hstep + kstep, voffB);
        PG8_WAIT_V(6); PG8_BAR;
    } else {
        PG8_STAGE(PG8_SB(0, 0), cB, voffB); PG8_STAGE(PG8_SA(0, 0), cA, voffA); PG8_STAGE(PG8_SB(0, 1), cB + hstep, voffB); PG8_STAGE(PG8_SA(0, 1), cA + hstep, voffA);
        if (wr == 1) PG8_BAR;
        PG8_WAIT_V(4); PG8_BAR;
        PG8_STAGE(PG8_SB(1, 0), cB + kstep, voffB); PG8_STAGE(PG8_SA(1, 0), cA + kstep, voffA); PG8_STAGE(PG8_SB(1, 1), cB + hstep + kstep, voffB);
        PG8_WAIT_V(6); PG8_BAR;
    }
    for (;;) {
        const bool has_next = S.next(ui + 1, nxt);
        const char* nA = has_next ? (const char*)g.A + (size_t)nxt.pm * tstep : cA; const char* nB = has_next ? (const char*)g.Bt + (size_t)nxt.pn * tstep : cB;
        for (int t = 0; t < nt; t += 2) {
            const bool last = (t == nt - 2);
            const char* a1 = cA + (size_t)(t + 1) * kstep;
            const char* a2 = last ? nA : cA + (size_t)(t + 2) * kstep; const char* b2 = last ? nB : cB + (size_t)(t + 2) * kstep;
            const char* a3 = a2 + kstep; const char* b3 = b2 + kstep;
            if (last && has_next) S.a_ready(nxt);
            if constexpr (SP2) {
            PG8_LDB(B0, 0, 0); PG8_LDB(B1, 0, 1); PG8_SCHED; PG8_LDA(At, 0, 0); PG8_STAGE(PG8_SA(1, 1), a1 + hstep, voffA);
            PG8_WAIT_V(8); PG8_WAIT_L(0); PG8_BAR; PG8_MMA(0, 0, At, B0); PG8_MMA(0, 1, At, B1); PG8_BAR; PG8_SCHED;
            PG8_LDA(At, 0, 1); PG8_STAGE(PG8_SB(0, 0), b2, voffB); PG8_STAGE(PG8_SB(0, 1), b2 + hstep, voffB); PG8_STAGE(PG8_SA(0, 0), a2, voffA);
            PG8_WAIT_V(8); PG8_WAIT_L(0); PG8_BAR; PG8_MMA(1, 0, At, B0); PG8_MMA(1, 1, At, B1); PG8_BAR; PG8_SCHED;
            PG8_LDB(B0, 1, 0); PG8_LDB(B1, 1, 1); PG8_SCHED; PG8_LDA(At, 1, 0); PG8_STAGE(PG8_SA(0, 1), a2 + hstep, voffA);
            PG8_WAIT_V(8); PG8_WAIT_L(0); PG8_BAR; PG8_MMA(0, 0, At, B0); PG8_MMA(0, 1, At, B1); PG8_BAR; PG8_SCHED;
            PG8_LDA(At, 1, 1); PG8_STAGE(PG8_SB(1, 0), b3, voffB); PG8_STAGE(PG8_SB(1, 1), b3 + hstep, voffB); PG8_STAGE(PG8_SA(1, 0), a3, voffA);
            PG8_WAIT_V(8); PG8_WAIT_L(0); PG8_BAR; PG8_MMA(1, 0, At, B0); PG8_MMA(1, 1, At, B1); PG8_BAR; PG8_SCHED;
            } else {
            PG8_LDB(B0, 0, 0); PG8_SCHED; PG8_LDA(At, 0, 0); PG8_STAGE(PG8_SA(1, 1), a1 + hstep, voffA);
            PG8_WAIT_L(8); PG8_BAR; PG8_WAIT_L(0); PG8_MMA(0, 0, At, B0); PG8_BAR; PG8_SCHED;
            PG8_LDB(B1, 0, 1); PG8_STAGE(PG8_SB(0, 0), b2, voffB);
            PG8_BAR; PG8_WAIT_L(0); PG8_MMA(0, 1, At, B1); PG8_BAR;
            PG8_LDA(At, 0, 1); PG8_STAGE(PG8_SA(0, 0), a2, voffA);
            PG8_BAR; PG8_WAIT_L(0); PG8_MMA(1, 0, At, B0); PG8_BAR; PG8_SCHED;
            PG8_STAGE(PG8_SB(0, 1), b2 + hstep, voffB);
            PG8_WAIT_V(6); PG8_BAR; PG8_MMA(1, 1, At, B1); PG8_BAR;
            PG8_LDB(B0, 1, 0); PG8_SCHED; PG8_LDA(At, 1, 0); PG8_STAGE(PG8_SA(0, 1), a2 + hstep, voffA);
            PG8_WAIT_L(8); PG8_BAR; PG8_WAIT_L(0); PG8_MMA(0, 0, At, B0); PG8_BAR; PG8_SCHED;
            PG8_LDB(B1, 1, 1); PG8_STAGE(PG8_SB(1, 0), b3, voffB);
            PG8_BAR; PG8_WAIT_L(0); PG8_MMA(0, 1, At, B1); PG8_BAR;
            PG8_LDA(At, 1, 1); PG8_STAGE(PG8_SA(1, 0), a3, voffA);
            PG8_BAR; PG8_WAIT_L(0); PG8_MMA(1, 0, At, B0); PG8_BAR; PG8_SCHED;
            PG8_STAGE(PG8_SB(1, 1), b3 + hstep, voffB);
            PG8_WAIT_V(6); PG8_BAR; PG8_MMA(1, 1, At, B1); PG8_BAR;
            }
        }
        if constexpr (ALIGN_EPI) { if (wr == 0) PG8_BAR; }
        if constexpr (!Epi::AFTER_DRAIN) { E(acc, cur, wr, wc, fr, fq); S.done(cur); }
        if (!has_next) break;
#pragma unroll
        for (int a = 0; a < 2; ++a)
#pragma unroll
            for (int b = 0; b < 2; ++b)
#pragma unroll
                for (int m = 0; m < 4; ++m)
#pragma unroll
                    for (int n = 0; n < 2; ++n) acc[a][b][m][n] = (f32x4){0.f, 0.f, 0.f, 0.f};
        cur = nxt; cA = nA; cB = nB; ++ui;
        if constexpr (ALIGN_EPI) { if (wr == 1) PG8_BAR; }
    }
    PG8_WAIT_V(0);
    if constexpr (!ALIGN_EPI) { if (wr == 0) PG8_BAR; }
    PG8_BAR;
    if constexpr (Epi::AFTER_DRAIN) { E.fused(acc, cur, wr, wc, fr, fq, lds, wid, lane); S.done(cur); }
#undef PG8_SA
#undef PG8_SB
#undef PG8_STAGE
#undef PG8_LDA
#undef PG8_LDB
#undef PG8_MMA
#undef PG8_WAIT_V
#undef PG8_WAIT_L
#undef PG8_BAR
#undef PG8_SCHED
}
}
#define XB_TMO      128
#define XB_XCNT(j)  (256  + 64 * (j))
#define XB_XSUB(j)  (1280 + 64 * (j))
#define XB_XGEN(j)  (2304 + 64 * (j))
#define XB_TOP      3328
#define XB_TOPGEN   3392
#define XCD_BAR_WORDS 3456
#define XB_SPIN_CAP (1u << 18)
#define LAS __attribute__((address_space(3)))

__device__ __forceinline__ unsigned xb_ld(unsigned* p)              { return __hip_atomic_load(p, __ATOMIC_RELAXED, __HIP_MEMORY_SCOPE_AGENT); }
__device__ __forceinline__ unsigned xb_add(unsigned* p, unsigned v) { return __hip_atomic_fetch_add(p, v, __ATOMIC_RELAXED, __HIP_MEMORY_SCOPE_AGENT); }
__device__ __forceinline__ unsigned xb_xcc_id() { return (unsigned)__builtin_amdgcn_s_getreg((3 << 11) | 20) & 0xFu; }
#define XB_SPIN(cond, bar) do { unsigned _sp = 0; while (cond) { __builtin_amdgcn_s_sleep(1); \
    if ((++_sp & 255u) == 0u) { if (xb_ld(&(bar)[XB_TMO])) break; if (_sp > XB_SPIN_CAP) { atomicAdd(&(bar)[XB_TMO], 1u); break; } } } } while (0)

struct XcdBarrier {
    unsigned* bar; unsigned x;
    volatile LAS unsigned* st;
};

__device__ __forceinline__ XcdBarrier xcd_barrier_post(unsigned* bar, volatile LAS unsigned* st) {
    XcdBarrier b; b.bar = bar; b.x = xb_xcc_id(); b.st = st;
    if (threadIdx.x == 0) (void)xb_add(&bar[XB_XCNT(b.x)], 1u);
    return b;
}
__device__ __forceinline__ void xcd_barrier_complete(unsigned* bar, unsigned x, unsigned& nloc, unsigned& nx) {
    const unsigned G = gridDim.x * gridDim.y * gridDim.z;
    unsigned sum, cnt, mine, sp = 0u;
    for (;;) {
        sum = 0u; cnt = 0u; mine = 0u;
#pragma unroll
        for (unsigned j = 0; j < 16; ++j) { const unsigned c = xb_ld(&bar[XB_XCNT(j)]); sum += c; cnt += (c > 0u) ? 1u : 0u; mine = (j == x) ? c : mine; }
        if (sum == G) break;
        __builtin_amdgcn_s_sleep(1);
        if ((++sp & 255u) == 0u) { if (xb_ld(&bar[XB_TMO])) break; if (sp > XB_SPIN_CAP) { atomicAdd(&bar[XB_TMO], 1u); break; } }
    }
    nloc = mine > 0u ? mine : 1u; nx = cnt > 0u ? cnt : 1u;
}

__device__ __forceinline__ void xcd_barrier(const XcdBarrier& b) {
    asm volatile("s_waitcnt vmcnt(0)" ::: "memory");
    __syncthreads();
    if (threadIdx.x == 0) {
        unsigned* bar = b.bar;
        __builtin_amdgcn_s_waitcnt(0);
        unsigned nloc = b.st[0], nx = b.st[1];
        if (nloc == 0u) { xcd_barrier_complete(bar, b.x, nloc, nx); b.st[0] = nloc; b.st[1] = nx; }
        const unsigned old = xb_add(&bar[XB_XSUB(b.x)], 1u);
        const unsigned gen = old / nloc;
        if (old + 1u == (gen + 1u) * nloc) {
            __builtin_amdgcn_fence(__ATOMIC_RELEASE, "agent");
            asm volatile("s_waitcnt vmcnt(0)" ::: "memory");
            const unsigned og = xb_add(&bar[XB_TOP], 1u);
            const unsigned tg = og / nx;
            if (og + 1u == (tg + 1u) * nx) xb_add(&bar[XB_TOPGEN], 1u);
            else XB_SPIN(xb_ld(&bar[XB_TOPGEN]) == tg, bar);
            __builtin_amdgcn_fence(__ATOMIC_ACQUIRE, "agent");
            xb_add(&bar[XB_XGEN(b.x)], 1u);
            asm volatile("s_waitcnt vmcnt(0)" ::: "memory");
        } else {
            XB_SPIN(xb_ld(&bar[XB_XGEN(b.x)]) == gen, bar);
            __builtin_amdgcn_fence(__ATOMIC_ACQUIRE, "agent");
            asm volatile("s_waitcnt vmcnt(0)" ::: "memory");
        }
    }
    __syncthreads();
}
constexpr int D = 2048, DEPTH = 4, NSEQ = 12, TOK = 40960, TP = 32768;
constexpr int NAH = 8, NRH = 16, DFF = 8192;
constexpr int LORA = 352;
constexpr int NPROJ = 6144, NIN = 7424;
constexpr int NQKV = 3072, NLB = 1280;
constexpr int NT64 = TOK / 64;
constexpr float NORM_EPS = 1e-6f, GN_EPS = 64e-5f;

constexpr size_t MiB = 1u << 20;
constexpr size_t WS_CTL = 0, CTL_ZERO_BYTES = 1 * MiB;
constexpr size_t WS_MOD = 1 * MiB;
constexpr size_t WS_LUP = 4 * MiB;
constexpr size_t WS_WIN = 8 * MiB;
constexpr size_t WS_WOUT = 66 * MiB;
constexpr size_t WS_XB = 82 * MiB;
constexpr size_t WS_WF1 = 242 * MiB;
constexpr size_t WS_WF2 = 274 * MiB;
constexpr size_t WS_VFIRST = 306 * MiB;
constexpr size_t WS_HB = 386 * MiB;
constexpr size_t WS_EX = 546 * MiB;
constexpr size_t WS_QKV = 706 * MiB;
constexpr size_t WS_RBUF = 946 * MiB;
constexpr size_t WS_LORA = 1186 * MiB;
constexpr size_t WS_MIXIN = 1286 * MiB;
constexpr size_t WS_KN = 1446 * MiB;
constexpr size_t WS_SSQ = 1454 * MiB;
constexpr size_t WS_G = 1456 * MiB;
constexpr size_t WS_END = 1536 * MiB;
constexpr size_t WS_HID = WS_QKV;
constexpr size_t PLANE = (size_t)TOK * 1024;
constexpr int LUP_W2 = 0, LUP_A2 = 131072, LUP_G2 = 262144, LUP_V2 = 327680, LUP_LAYER = 360448;
constexpr int CW_BAR = 4096;

constexpr int LDS_BYTES = 163840;
constexpr int L_RING = 0;
constexpr int L_BIAS = 131072;
constexpr int L_EXCH = 147456;
constexpr int L_MISC = 163584;
constexpr int L_TRS = 8448;
constexpr int L_PRM = 69632;

#define DI __device__ __forceinline__
typedef unsigned short bf16;
typedef unsigned u32x4 __attribute__((ext_vector_type(4)));
typedef unsigned u32x2 __attribute__((ext_vector_type(2)));
typedef float f32x4 __attribute__((ext_vector_type(4)));
typedef float f32x2 __attribute__((ext_vector_type(2)));
typedef float f32x16 __attribute__((ext_vector_type(16)));
typedef short bf16x8 __attribute__((ext_vector_type(8)));
typedef short s16x4 __attribute__((ext_vector_type(4)));
typedef _Float16 f16x2 __attribute__((ext_vector_type(2)));

DI float bflo(unsigned w) { return __uint_as_float(w << 16); }
DI float bfhi(unsigned w) { return __uint_as_float(w & 0xffff0000u); }
DI unsigned f2bf(float f) { unsigned u = __float_as_uint(f); return (u + 0x7fffu + ((u >> 16) & 1u)) >> 16; }
typedef __bf16 bf16v2_t __attribute__((ext_vector_type(2)));
DI unsigned pkbf(float lo, float hi) { return __builtin_bit_cast(unsigned, __builtin_convertvector((f32x2){lo, hi}, bf16v2_t)); }
DI unsigned pk2(float lo, float hi) { return pkbf(lo, hi); }
DI unsigned pkh2(float lo, float hi) { f16x2 v; v.x = (_Float16)lo; v.y = (_Float16)hi; return __builtin_bit_cast(unsigned, v); }
DI float hlo(unsigned w) { return (float)__builtin_bit_cast(f16x2, w).x; }
DI float hhi(unsigned w) { return (float)__builtin_bit_cast(f16x2, w).y; }
DI float h2f(unsigned short h) { return (float)__builtin_bit_cast(_Float16, h); }
DI unsigned short f2h(float f) { return __builtin_bit_cast(unsigned short, (_Float16)f); }
DI float wave_sum(float v) {
#pragma unroll
    for (int o = 1; o < 64; o <<= 1) v += __shfl_xor(v, o);
    return v;
}
#define DPP_ROR_ADD(v, n) ((v) + __builtin_bit_cast(float, __builtin_amdgcn_update_dpp(0, __builtin_bit_cast(int, (v)), 0x120 + (n), 0xf, 0xf, false)))
DI float wave_sum_dpp(float v) {
    v = DPP_ROR_ADD(v, 8); v = DPP_ROR_ADD(v, 4); v = DPP_ROR_ADD(v, 2); v = DPP_ROR_ADD(v, 1);
    const int b = __builtin_bit_cast(int, v);
    return (__builtin_bit_cast(float, __builtin_amdgcn_readlane(b, 0)) + __builtin_bit_cast(float, __builtin_amdgcn_readlane(b, 16))) +
           (__builtin_bit_cast(float, __builtin_amdgcn_readlane(b, 32)) + __builtin_bit_cast(float, __builtin_amdgcn_readlane(b, 48)));
}
DI float sigmoidf_(float x) { return __builtin_amdgcn_rcpf(1.0f + __expf(-x)); }
DI float tanhf_(float x) { const float e = __expf(2.0f * x); return 1.0f - 2.0f * __builtin_amdgcn_rcpf(1.0f + e); }
DI int seq_start(int s) { return s < 8 ? s * 4096 : TP + (s - 8) * 2048; }
DI int seq_len(int s) { return s < 8 ? 4096 : 2048; }
DI void tokinfo(int m, int& s, int& t, int& T) { if (m < TP) { s = m >> 12; t = m & 4095; T = 4096; } else { const int mm = m - TP; s = 8 + (mm >> 11); t = mm & 2047; T = 2048; } }

struct Args { const float* in[35]; float* out; unsigned char* ws; int ph_lo, ph_hi; };
typedef const __attribute__((address_space(4))) Args CArgs;
enum { I_XP = 0, I_XS, I_CP, I_CS, I_WADA, I_BADA, I_GPREMIX, I_GPOSTMIX, I_GPREFFN, I_GPOSTFFN, I_WIN, I_RPB, I_GATT, I_MURKV, I_MUX, I_W0, I_W1, I_W2, I_A0, I_A1, I_A2,
       I_G1, I_G2, I_MUV, I_V0, I_V1, I_V2, I_KK, I_KA, I_RK, I_LNW, I_LNB, I_WOUT, I_WF1, I_WF2 };
DI const float* mod_ptr(CArgs& a, int l, int s, int k) { return (const float*)(a.ws + WS_MOD) + ((size_t)(l * NSEQ + s) * 6 + k) * D; }
template <int KB>
DI void transpose_item(const float* W, int K, int N, bf16* WT, int row_off, LAS float* scr, int item, int lane, const float* mu, int variant) {
    const int nblk = N / 32, kb = item / nblk, nb = item % nblk, k0 = KB * kb, n0 = 32 * nb;
#pragma unroll 8
    for (int i = 0; i < KB / 2; ++i) { const int kk = 2 * i + (lane >> 5); float v = W ? W[(size_t)(k0 + kk) * N + n0 + (lane & 31)] : 0.f;
        if (mu) { const float m0 = mu[k0 + kk], m1 = mu[K + k0 + kk]; v *= (variant == 0) ? (1.0f - m0 - m1) : (variant == 1 ? m0 : m1); }
        scr[kk * 33 + (lane & 31)] = v; }
    asm volatile("s_waitcnt lgkmcnt(0)" ::: "memory");
    constexpr int CH = KB / 8, RPP = 64 / CH;
    const int c = lane % CH;
#pragma unroll
    for (int j = 0; j < 32 / RPP; ++j) { const int n = lane / CH + RPP * j; const LAS float* s = scr + (8 * c) * 33 + n;
        u32x4 o; o.x = pk2(s[0 * 33], s[1 * 33]); o.y = pk2(s[2 * 33], s[3 * 33]); o.z = pk2(s[4 * 33], s[5 * 33]); o.w = pk2(s[6 * 33], s[7 * 33]);
        *(u32x4*)(WT + (size_t)(row_off + n0 + n) * K + k0 + 8 * c) = o; }
    asm volatile("s_waitcnt lgkmcnt(0)" ::: "memory");
}
template <int KB> DI void ffn_weight_item(CArgs& a, int l, int it, LAS float* scr, int lane) {
    constexpr int S = 64 / KB;
    if (it < 8192 * S) transpose_item<KB>(a.in[I_WF1] + (size_t)l * D * DFF, D, DFF, (bf16*)(a.ws + WS_WF1), 0, scr, it, lane, nullptr, 0);
    else transpose_item<KB>(a.in[I_WF2] + (size_t)l * DFF * D, DFF, D, (bf16*)(a.ws + WS_WF2), 0, scr, it - 8192 * S, lane, nullptr, 0);
}
constexpr int IT_WIN = 6144, IT_LORA = 1056, IT_WOUT = 2048, IT_LAYER = IT_WIN + IT_LORA + IT_WOUT;
template <int KB> DI void layer_weight_item(CArgs& a, int l, int r, LAS float* scr, int lane) {
    constexpr int S = 64 / KB;
    bf16* wint = (bf16*)(a.ws + WS_WIN) + (size_t)(l & 1) * NIN * D;
    if (r < IT_WIN * S) { transpose_item<KB>(a.in[I_WIN] + (size_t)l * D * NPROJ, D, NPROJ, wint, 0, scr, r, lane, nullptr, 0); return; }
    r -= IT_WIN * S;
    if (r < IT_LORA * S) {
        if (r < 960 * S) { const int mat = r / (192 * S), variant = (r % (192 * S)) / (64 * S), item = r % (64 * S);
            const float* W; const float* mu;
            if (mat < 2) { W = a.in[I_W1] + (size_t)(l * 2 + mat) * D * 64; mu = a.in[I_MUX] + (size_t)(l * 3 + 0) * 2 * D; }
            else if (mat < 4) { W = a.in[I_A1] + (size_t)(l * 2 + (mat - 2)) * D * 64; mu = a.in[I_MUX] + (size_t)(l * 3 + 1) * 2 * D; }
            else { W = a.in[I_G1] + (size_t)l * D * 64; mu = a.in[I_MUX] + (size_t)(l * 3 + 2) * 2 * D; }
            transpose_item<KB>(W, D, 64, wint, NPROJ + variant * LORA + 64 * mat, scr, item, lane, mu, variant);
        } else { const int jj = r - 960 * S, variant = jj / (32 * S), item = jj % (32 * S);
            const float* W = l > 0 ? a.in[I_V1] + (size_t)(l - 1) * D * 32 : nullptr; const float* mu = l > 0 ? a.in[I_MUV] + (size_t)(l - 1) * 2 * D : nullptr;
            transpose_item<KB>(W, D, 32, wint, NPROJ + variant * LORA + 320, scr, item, lane, mu, variant); }
        return; }
    r -= IT_LORA * S;
    transpose_item<KB>(a.in[I_WOUT] + (size_t)l * D * D, D, D, (bf16*)(a.ws + WS_WOUT) + (size_t)(l & 1) * D * D, 0, scr, r, lane, nullptr, 0);
}
constexpr int BG_FFN = 16384 * 2, BG_LAYER = IT_LAYER * 2;
DI void bg_decode(CArgs& a, int l, int it, const float*& W, const float*& mu, bf16*& WT, int& K, int& N, int& row_off, int& item, int& variant) {
    mu = nullptr; variant = 0; row_off = 0;
    if (it < BG_FFN) {
        if (it < 16384) { W = a.in[I_WF1] + (size_t)l * D * DFF; K = D; N = DFF; WT = (bf16*)(a.ws + WS_WF1); item = it; }
        else { W = a.in[I_WF2] + (size_t)l * DFF * D; K = DFF; N = D; WT = (bf16*)(a.ws + WS_WF2); item = it - 16384; }
        return; }
    const int ln = l + 1; int r = it - BG_FFN;
    bf16* wint = (bf16*)(a.ws + WS_WIN) + (size_t)(ln & 1) * NIN * D;
    if (r < 2 * IT_WIN) { W = a.in[I_WIN] + (size_t)ln * D * NPROJ; K = D; N = NPROJ; WT = wint; item = r; return; }
    r -= 2 * IT_WIN;
    if (r < 2 * IT_LORA) { K = D; WT = wint;
        if (r < 1920) { const int mat = r / 384; variant = (r % 384) / 128; item = r % 128; N = 64;
            if (mat < 2) { W = a.in[I_W1] + (size_t)(ln * 2 + mat) * D * 64; mu = a.in[I_MUX] + (size_t)(ln * 3 + 0) * 2 * D; }
            else if (mat < 4) { W = a.in[I_A1] + (size_t)(ln * 2 + (mat - 2)) * D * 64; mu = a.in[I_MUX] + (size_t)(ln * 3 + 1) * 2 * D; }
            else { W = a.in[I_G1] + (size_t)ln * D * 64; mu = a.in[I_MUX] + (size_t)(ln * 3 + 2) * 2 * D; }
            row_off = NPROJ + variant * LORA + 64 * mat; }
        else { const int jj = r - 1920; variant = jj / 64; item = jj % 64; N = 32;
            W = ln > 0 ? a.in[I_V1] + (size_t)(ln - 1) * D * 32 : nullptr; mu = ln > 0 ? a.in[I_MUV] + (size_t)(ln - 1) * 2 * D : nullptr; row_off = NPROJ + variant * LORA + 320; }
        return; }
    r -= 2 * IT_LORA;
    W = a.in[I_WOUT] + (size_t)ln * D * D; K = D; N = D; WT = (bf16*)(a.ws + WS_WOUT) + (size_t)(ln & 1) * D * D; item = r;
    mu = a.in[I_GATT] + (size_t)ln * 1024; variant = 3;
}
DI void bg_issue(CArgs& a, int l, int it, int lane, f32x4 (&nx)[4]) {
    const float* W; const float* mu; bf16* WT; int K, N, row_off, item, variant;
    bg_decode(a, l, it, W, mu, WT, K, N, row_off, item, variant);
    const int nblk = N >> 5, k0 = 32 * (item / nblk), n0 = 32 * (item % nblk);
    if (!W) {
#pragma unroll
        for (int i = 0; i < 4; ++i) nx[i] = (f32x4){0.f, 0.f, 0.f, 0.f};
        return; }
    const float* p = W + (size_t)(k0 + (lane >> 3)) * N + n0 + 4 * (lane & 7);
#pragma unroll
    for (int i = 0; i < 4; ++i) nx[i] = *(const f32x4*)(p + (size_t)(8 * i) * N);
}
DI void background_weights(CArgs& a, int l, LAS float* scr, int slot, int nslots, int lane) {
    const int total = BG_FFN + (l < 3 ? BG_LAYER : 0);
    f32x4 nx[4];
    int it = (l < 0 ? BG_FFN : 0) + slot;
    if (it < total) bg_issue(a, l, it, lane, nx);
#pragma unroll 1
    for (; it < total; it += nslots) {
        f32x4 v[4];
#pragma unroll
        for (int i = 0; i < 4; ++i) v[i] = nx[i];
        if (it + nslots < total) bg_issue(a, l, it + nslots, lane, nx);
        const float* W; const float* mu; bf16* WT; int K, N, row_off, item, variant;
        bg_decode(a, l, it, W, mu, WT, K, N, row_off, item, variant);
        const int nblk = N >> 5, k0 = 32 * (item / nblk), n0 = 32 * (item % nblk), rr = lane >> 3, cc = 4 * (lane & 7);
#pragma unroll
        for (int i = 0; i < 4; ++i) { const int kk = 8 * i + rr; float sc = 1.0f;
            if (mu) { if (variant == 3) { if (k0 < 1024) sc = mu[k0 + kk]; }
                      else { const float m0 = mu[k0 + kk], m1 = mu[K + k0 + kk]; sc = (variant == 0) ? (1.0f - m0 - m1) : (variant == 1 ? m0 : m1); } }
            LAS float* sp = scr + kk * 33 + cc; sp[0] = v[i].x * sc; sp[1] = v[i].y * sc; sp[2] = v[i].z * sc; sp[3] = v[i].w * sc; }
        asm volatile("s_waitcnt lgkmcnt(0)" ::: "memory");
        const int c = lane & 3;
#pragma unroll
        for (int j = 0; j < 2; ++j) { const int n = (lane >> 2) + 16 * j; const LAS float* sq = scr + (8 * c) * 33 + n;
            u32x4 o; o.x = pk2(sq[0 * 33], sq[1 * 33]); o.y = pk2(sq[2 * 33], sq[3 * 33]); o.z = pk2(sq[4 * 33], sq[5 * 33]); o.w = pk2(sq[6 * 33], sq[7 * 33]);
            *(u32x4*)(WT + (size_t)(row_off + n0 + n) * K + k0 + 8 * c) = o; }
        asm volatile("s_waitcnt lgkmcnt(0)" ::: "memory");
    }
}

DI void phase_prologue(CArgs& a, LAS unsigned char* lds, int tid, int lane, int wave, int G) {
    {   LAS float* sc = (LAS float*)(lds);
        LAS float* part = (LAS float*)(lds + 98304);
        bool have = false;
        for (int it = blockIdx.x; it < 4 * 96; it += G) {
            if (!have) {
#pragma unroll 1
                for (int i0 = tid; i0 < NSEQ * D; i0 += 512 * 8) { float cv[8];
#pragma unroll
                    for (int u = 0; u < 8; ++u) { const int i = i0 + 512 * u, s = i / D, k = i % D; cv[u] = s < 8 ? a.in[I_CP][s * D + k] : a.in[I_CS][(s - 8) * D + k]; }
#pragma unroll
                    for (int u = 0; u < 8; ++u) { const int i = i0 + 512 * u, s = i / D, k = i % D; const float c = cv[u]; sc[k * 12 + s] = c / (1.0f + __expf(-c)); } }
                __syncthreads(); have = true; }
            const int l = it / 96, n0 = (it % 96) * 128;
            const float* W = a.in[I_WADA] + (size_t)l * D * 12288 + n0 + 2 * lane;
            f32x2 acc[12];
#pragma unroll
            for (int s = 0; s < 12; ++s) acc[s] = (f32x2){0.f, 0.f};
#pragma unroll 16
            for (int k = wave * 256; k < wave * 256 + 256; ++k) { const f32x2 wv = *(const f32x2*)(W + (size_t)k * 12288); const LAS f32x4* sp = (const LAS f32x4*)(sc + k * 12); const f32x4 s0 = sp[0], s1 = sp[1], s2 = sp[2];
                acc[0] += s0.x * wv; acc[1] += s0.y * wv; acc[2] += s0.z * wv; acc[3] += s0.w * wv; acc[4] += s1.x * wv; acc[5] += s1.y * wv; acc[6] += s1.z * wv; acc[7] += s1.w * wv;
                acc[8] += s2.x * wv; acc[9] += s2.y * wv; acc[10] += s2.z * wv; acc[11] += s2.w * wv; }
#pragma unroll
            for (int s = 0; s < 12; ++s) *(LAS f32x2*)(part + (wave * 12 + s) * 128 + 2 * lane) = acc[s];
            __syncthreads();
            for (int o = tid; o < 12 * 128; o += 512) { const int s = o / 128, c = o % 128; float v = a.in[I_BADA][l * 12288 + n0 + c];
#pragma unroll
                for (int w = 0; w < 8; ++w) v += part[(w * 12 + s) * 128 + c];
                ((float*)(a.ws + WS_MOD))[(size_t)(l * NSEQ + s) * 12288 + n0 + c] = v; }
            __syncthreads();
        }
        __syncthreads();
    }
    {   LAS float* scr = (LAS float*)(lds + wave * L_TRS);
        const int gw = blockIdx.x * 8 + wave, NGW = G * 8;
        background_weights(a, -1, scr, gw, NGW, lane);
    }
    {   bf16* lup = (bf16*)(a.ws + WS_LUP);
        for (int e = blockIdx.x * 512 + tid; e < 4 * LUP_LAYER; e += G * 512) { const int l = e / LUP_LAYER, r = e % LUP_LAYER; float v;
            if (r < LUP_A2) { const int d = r >> 16, ch = (r & 65535) >> 6, k = r & 63; v = a.in[I_W2][((size_t)(l * 2 + d) * 64 + k) * 1024 + ch]; }
            else if (r < LUP_G2) { const int q = r - LUP_A2, d = q >> 16, ch = (q & 65535) >> 6, k = q & 63; v = a.in[I_A2][((size_t)(l * 2 + d) * 64 + k) * 1024 + ch]; }
            else if (r < LUP_V2) { const int q = r - LUP_G2, ch = q >> 6, k = q & 63; v = a.in[I_G2][((size_t)l * 64 + k) * 1024 + ch]; }
            else { const int q = r - LUP_V2, ch = q >> 5, k = q & 31; v = l > 0 ? a.in[I_V2][((size_t)(l - 1) * 32 + k) * 1024 + ch] : 0.f; }
            lup[e] = (bf16)f2bf(v); }
    }
}

DI void phase_resnorm(CArgs& a, LAS unsigned char* lds, int l, int mode, int tid, int lane, int wave, int G) {
    LAS float* prm = (LAS float*)(lds + L_PRM);
    const bf16* src = mode == 1 ? (const bf16*)(a.ws + WS_RBUF) : (const bf16*)(a.ws + WS_EX);
    bf16* hb = (bf16*)(a.ws + WS_HB);
    const bool do_h = (mode != 2) || (l < 3);
    const int ln = (mode == 2) ? l + 1 : l;
    const int rpb = (TOK + G - 1) / G, mb = min((int)blockIdx.x * rpb, TOK), me = min(mb + rpb, TOK);
    for (int m0 = mb; m0 < me; ) {
        int s, t0, T; tokinfo(m0, s, t0, T);
        const int mend = min(me, m0 - t0 + T);
        __syncthreads();
#pragma unroll
        for (int i = tid; i < D; i += 512) {
            float gpost = 0.f, gate = 0.f, gpre = 0.f, sc = 0.f, sh = 0.f;
            if (mode == 1) { gpost = a.in[I_GPOSTMIX][l * D + i]; gate = mod_ptr(a, l, s, 2)[i]; gpre = a.in[I_GPREFFN][l * D + i]; sc = mod_ptr(a, l, s, 4)[i]; sh = mod_ptr(a, l, s, 3)[i]; }
            else { if (mode == 2) { gpost = a.in[I_GPOSTFFN][l * D + i]; gate = mod_ptr(a, l, s, 5)[i]; }
                   if (do_h) { gpre = a.in[I_GPREMIX][ln * D + i]; sc = mod_ptr(a, ln, s, 1)[i]; sh = mod_ptr(a, ln, s, 0)[i]; } }
            prm[i] = gpost; prm[D + i] = gate; prm[2 * D + i] = gpre; prm[3 * D + i] = sc; prm[4 * D + i] = sh; }
        __syncthreads();
        const bool xin_f32 = (mode == 0) || (mode == 1 && l == 0);
        const bool xout_f32 = (mode == 2 && l == DEPTH - 1);
        bf16* xb = (bf16*)(a.ws + WS_XB);
#define RN_LOAD(mm_) do { if (xin_f32) { const float* xp_ = (mm_) < TP ? a.in[I_XP] + (size_t)(mm_) * D : a.in[I_XS] + (size_t)((mm_) - TP) * D; \
                _Pragma("unroll") for (int j = 0; j < 8; ++j) xn[j] = __builtin_nontemporal_load((const f32x4*)xp_ + lane + 64 * j); } \
            else { _Pragma("unroll") for (int j = 0; j < 8; ++j) { const u32x2 w_ = __builtin_nontemporal_load((const u32x2*)(xb + (size_t)(mm_) * D) + lane + 64 * j); xn[j] = (f32x4){bflo(w_.x), bfhi(w_.x), bflo(w_.y), bfhi(w_.y)}; } } \
            if (mode != 0) { _Pragma("unroll") for (int j = 0; j < 8; ++j) sn[j] = __builtin_nontemporal_load((const u32x2*)(src + (size_t)(mm_) * D + 4 * (lane + 64 * j))); } \
            if (mode == 1) { qn0 = *(const f32x4*)(ssqa + (size_t)(mm_) * 8); qn1 = *(const f32x4*)(ssqa + (size_t)(mm_) * 8 + 4); } } while (0)
        const float* ssqa = (const float*)(a.ws + WS_SSQ);
        f32x4 qn0 = (f32x4){0.f, 0.f, 0.f, 0.f}, qn1 = qn0;
        f32x4 xn[8]; u32x2 sn[8];
#pragma unroll
        for (int j = 0; j < 8; ++j) sn[j] = (u32x2){0u, 0u};
        if (m0 + wave < mend) RN_LOAD(m0 + wave);
#pragma unroll 1
        for (int m = m0 + wave; m < mend; m += 8) {
            f32x4 x[8]; u32x2 sv[8];
#pragma unroll
            for (int j = 0; j < 8; ++j) { x[j] = xn[j]; sv[j] = sn[j]; }
            const float eps1 = (mode == 1) ? NORM_EPS * (((qn0.x + qn0.y) + (qn0.z + qn0.w) + (qn1.x + qn1.y) + (qn1.z + qn1.w)) * (1.0f / 1024.0f) + NORM_EPS) : NORM_EPS;
            if (m + 8 < mend) RN_LOAD(m + 8);
            if (mode != 0) {
                f32x4 v[8]; float ss = 0.f;
#pragma unroll
                for (int j = 0; j < 8; ++j) { const u32x2 w = sv[j]; v[j] = (f32x4){bflo(w.x), bfhi(w.x), bflo(w.y), bfhi(w.y)};
                    ss += (v[j].x * v[j].x + v[j].y * v[j].y) + (v[j].z * v[j].z + v[j].w * v[j].w); }
                const float rstd = __builtin_amdgcn_rsqf(wave_sum_dpp(ss) * (1.0f / D) + eps1);
#pragma unroll
                for (int j = 0; j < 8; ++j) { const f32x4 gp = *(const LAS f32x4*)(prm + 4 * (lane + 64 * j)), gt = *(const LAS f32x4*)(prm + D + 4 * (lane + 64 * j));
                    x[j] = x[j] + gt * (v[j] * rstd * gp);
                    if (xout_f32) __builtin_nontemporal_store(x[j], (f32x4*)(a.out + (size_t)m * D) + lane + 64 * j);
                    else { u32x2 w; w.x = pk2(x[j].x, x[j].y); w.y = pk2(x[j].z, x[j].w); __builtin_nontemporal_store(w, (u32x2*)(xb + (size_t)m * D) + lane + 64 * j); } }
            }
            if (do_h) {
                float ss = 0.f;
#pragma unroll
                for (int j = 0; j < 8; ++j) ss += (x[j].x * x[j].x + x[j].y * x[j].y) + (x[j].z * x[j].z + x[j].w * x[j].w);
                const float rstd = __builtin_amdgcn_rsqf(wave_sum_dpp(ss) * (1.0f / D) + NORM_EPS);
#pragma unroll
                for (int j = 0; j < 8; ++j) { const int c = 4 * (lane + 64 * j); const f32x4 gp = *(const LAS f32x4*)(prm + 2 * D + c), sc = *(const LAS f32x4*)(prm + 3 * D + c), sh = *(const LAS f32x4*)(prm + 4 * D + c);
                    const f32x4 h = x[j] * rstd * gp * (1.0f + sc) + sh; u32x2 w; w.x = pk2(h.x, h.y); w.y = pk2(h.z, h.w); *(u32x2*)(hb + (size_t)m * D + c) = w;
                    if ((j & 1) == 1) asm volatile("" ::: "memory"); }
            }
        }
#undef RN_LOAD
        m0 = mend;
    }
}
#define MFMA32(a, b, c) __builtin_amdgcn_mfma_f32_32x32x16_bf16((a), (b), (c), 0, 0, 0)
DI int v_off(int row, int ch) { return 256 * row + 16 * (ch ^ (((row & 3) << 2) | ((row >> 2) & 3))); }
DI s16x4 tr_read(const LAS unsigned char* p) { return __builtin_amdgcn_ds_read_tr16_b64_v4i16((LAS s16x4*)p); }
DI bf16x8 pack8(const f32x16& x, int s) {
    u32x4 p; p.x = pk2(x[8 * s + 0], x[8 * s + 1]); p.y = pk2(x[8 * s + 2], x[8 * s + 3]); p.z = pk2(x[8 * s + 4], x[8 * s + 5]); p.w = pk2(x[8 * s + 6], x[8 * s + 7]);
    return __builtin_bit_cast(bf16x8, p);
}
template <int V> struct IntC { static constexpr int value = V; };
template <int QH>
DI void att_tile(f32x16 (&o)[4], float& mrun, float& lrun, const LAS unsigned char* kt, const LAS unsigned char* vt, const LAS unsigned char* qt, const int (&vofs)[4][2],
                 const LAS float* bp, int dv, int rq, int h, float scale) {
    constexpr int FB = 1 - QH, NB = QH, FV0 = QH ? 12 : 0, FS2 = QH ? 1 : 0;
#define LIVE(kb_, i_) ((kb_) == NB || ((i_) >= FV0 && (i_) < FV0 + 4))
    f32x16 st[2];
#pragma unroll
    for (int kb = 0; kb < 2; ++kb)
#pragma unroll
        for (int i = 0; i < 16; ++i) st[kb][i] = 0.f;
    bf16x8 qf[8], kf[8][2];
#define QK_LOAD(ks_) do { qf[ks_] = *(const LAS bf16x8*)(qt + v_off(rq, 2 * (ks_) + h)); kf[ks_][0] = *(const LAS bf16x8*)(kt + v_off(rq, 2 * (ks_) + h)); kf[ks_][1] = *(const LAS bf16x8*)(kt + v_off(32 + rq, 2 * (ks_) + h)); } while (0)
    __builtin_amdgcn_sched_barrier(0);
    QK_LOAD(0);
    __builtin_amdgcn_sched_barrier(0);
#pragma unroll
    for (int ks = 0; ks < 8; ++ks) {
        st[0] = MFMA32(kf[ks][0], qf[ks], st[0]); st[1] = MFMA32(kf[ks][1], qf[ks], st[1]);
        if (ks + 1 < 8) QK_LOAD(ks + 1);
        __builtin_amdgcn_sched_barrier(0); }
#undef QK_LOAD
    bf16x8 vf[12];
#define PV_KB(g_) (((g_) >> 2) == 2 ? FB : NB)
#define PV_S2(g_) (((g_) >> 2) == 2 ? FS2 : ((g_) >> 2))
#define PV_LOAD(g_) do { const int kb_ = PV_KB(g_), s2_ = PV_S2(g_), db_ = (g_) & 3; \
        const s16x4 lo_ = tr_read(vt + vofs[db_][0] + 256 * (32 * kb_ + 16 * s2_)), hi_ = tr_read(vt + vofs[db_][1] + 256 * (32 * kb_ + 16 * s2_)); \
        vf[g_] = __builtin_shufflevector(lo_, hi_, 0, 1, 2, 3, 4, 5, 6, 7); } while (0)
    PV_LOAD(0); PV_LOAD(1);
    __builtin_amdgcn_sched_barrier(0);
    float mx = -1e30f;
#pragma unroll
    for (int kb = 0; kb < 2; ++kb) {
        float bv[16];
#pragma unroll
        for (int i = 0; i < 16; ++i) bv[i] = LIVE(kb, i) ? bp[32 * kb + (i & 3) + 8 * (i >> 2)] : 0.f;
#pragma unroll
        for (int i = 0; i < 16; ++i) if (LIVE(kb, i)) { const int cc = 32 * kb + (i & 3) + 8 * (i >> 2); const bool valid = (unsigned)(cc + dv) < 16u;
            const float sb = fmaf(st[kb][i], scale, bv[i]); const float sv2 = valid ? sb : -1e30f; st[kb][i] = sv2; mx = fmaxf(mx, sv2); }
        __builtin_amdgcn_sched_barrier(0); }
    mx = fmaxf(mx, __shfl_xor(mx, 32));
    const float mnew = fmaxf(mrun, mx), alpha = __builtin_amdgcn_exp2f(mrun - mnew);
    float psum = 0.f;
#pragma unroll
    for (int kb = 0; kb < 2; ++kb)
#pragma unroll
        for (int i = 0; i < 16; ++i) { if (LIVE(kb, i)) { const float p = __builtin_amdgcn_exp2f(st[kb][i] - mnew); st[kb][i] = p; psum += p; } else st[kb][i] = 0.f; }
    lrun = lrun * alpha + psum; mrun = mnew;
#pragma unroll
    for (int db = 0; db < 4; ++db)
#pragma unroll
        for (int i = 0; i < 16; ++i) o[db][i] *= alpha;
    __builtin_amdgcn_sched_barrier(0);
#pragma unroll
    for (int g = 0; g < 12; ++g) { const bf16x8 pf = pack8(st[PV_KB(g)], PV_S2(g));
        o[g & 3] = MFMA32(vf[g], pf, o[g & 3]);
        if (g + 2 < 12) PV_LOAD(g + 2);
        __builtin_amdgcn_sched_barrier(0); }
#undef PV_LOAD
#undef PV_KB
#undef PV_S2
#undef LIVE
}
DI void phase_attention(CArgs& a, LAS unsigned char* lds, int l, int tid, int lane, int wave, int G) {
    const bf16* qkv = (const bf16*)(a.ws + WS_QKV);
    bf16* mixin = (bf16*)(a.ws + WS_MIXIN);
    float* ssqo = (float*)(a.ws + WS_SSQ);
    LAS float* bt = (LAS float*)(lds + L_BIAS);
    const int rq = lane & 31, h = lane >> 5;
    const float scale = 0.08838834764831845f * 1.4426950408889634f;
    int vofs[4][2];
    { const int g16 = lane & 15, qq = g16 >> 2, pp = g16 & 3, blk = (lane >> 4) & 1;
#pragma unroll
      for (int db = 0; db < 4; ++db)
#pragma unroll
          for (int hi = 0; hi < 2; ++hi) vofs[db][hi] = v_off(4 * h + qq + 8 * hi, 4 * db + 2 * blk + (pp >> 1)) + 8 * (pp & 1); }
    const int skey0 = tid >> 4, sch = tid & 15;
    for (int u = blockIdx.x; u < (TOK / 256) * NAH; u += G) {
        const int head = u & 7, m0 = (u >> 3) * 256; int s, t0, T; tokinfo(m0, s, t0, T);
        const int r0 = t0 >> 6, rows = T >> 6, sbase = m0 - t0;
        const int r = r0 + (wave >> 1), qh = wave & 1;
        const int rs = min(max(r - 4, 0), rows - 8);
        const int klo = min(max(r0 - 4, 0), rows - 8), khi = min(max(r0 + 3 - 4, 0), rows - 8) + 8, nt = khi - klo;
        const int q = 32 * qh + rq, mq = m0 + 64 * (wave >> 1) + q;
        const int cs = min(max(q - 8, 0), 48);
        __syncthreads();
        LAS unsigned char* qt = lds + 65536 + wave * 8192;
        u32x4 sk[2][2], sv[2][2];
#define KV_FETCH(set_, row_) do { const bf16* kp_ = qkv + (size_t)(sbase + (row_) * 64 + skey0) * NQKV + head * 128 + sch * 8; \
            _Pragma("unroll") for (int i_ = 0; i_ < 2; ++i_) { sk[set_][i_] = *(const u32x4*)(kp_ + (size_t)(32 * i_) * NQKV + 1024); sv[set_][i_] = *(const u32x4*)(kp_ + (size_t)(32 * i_) * NQKV + 2048); } } while (0)
        {   const float bias_v = a.in[I_RPB][(size_t)(l * NAH + head) * 465 + min(tid, 15 * 31 - 1)];
            u32x4 qreg[8];
            const bf16* qp = qkv + (size_t)(m0 + 64 * (wave >> 1) + 32 * qh) * NQKV + head * 128;
#pragma unroll
            for (int i = 0; i < 8; ++i) { const int p = i * 64 + lane, row = p >> 4, ch = p & 15; qreg[i] = *(const u32x4*)(qp + (size_t)row * NQKV + ch * 8); }
            KV_FETCH(0, klo);
            KV_FETCH(1, klo + 1);
            __builtin_amdgcn_sched_barrier(0);
            if (tid < 15 * 31) bt[tid] = 1.4426950408889634f * bias_v;
#pragma unroll
            for (int i = 0; i < 8; ++i) { const int p = i * 64 + lane, row = p >> 4, ch = p & 15; *(LAS u32x4*)(qt + v_off(row, ch)) = qreg[i]; }
#pragma unroll
            for (int i = 0; i < 2; ++i) { *(LAS u32x4*)(lds + v_off(skey0 + 32 * i, sch)) = sk[0][i]; *(LAS u32x4*)(lds + 16384 + v_off(skey0 + 32 * i, sch)) = sv[0][i]; }
        }
        f32x16 o[4];
#pragma unroll
        for (int db = 0; db < 4; ++db)
#pragma unroll
            for (int i = 0; i < 16; ++i) o[db][i] = 0.f;
        float mrun = -1e30f, lrun = 0.f;
        __syncthreads();
        auto tile_loop = [&](auto qhc) __attribute__((always_inline)) {
        constexpr int QH = decltype(qhc)::value;
#pragma unroll 1
        for (int it0 = 0; it0 < nt; it0 += 2) {
#pragma unroll
        for (int half = 0; half < 2; ++half) {
            const int it = it0 + half; if (it >= nt) break;
            const int R = klo + it;
            LAS unsigned char* kt = lds + half * 32768; LAS unsigned char* vt = kt + 16384;
            if (it + 2 < nt) KV_FETCH(half, R + 2);
            if (R >= rs && R < rs + 8) {
                int dv = 4 * h - cs; asm volatile("" : "+v"(dv));
                const LAS float* bp = bt + (R - r + 7) * 31 + (4 * h - q + 15);
                att_tile<QH>(o, mrun, lrun, kt, vt, qt, vofs, bp, dv, rq, h, scale);
            }
            if (it + 1 < nt) { LAS unsigned char* kn = lds + (1 - half) * 32768;
#pragma unroll
                for (int i = 0; i < 2; ++i) { *(LAS u32x4*)(kn + v_off(skey0 + 32 * i, sch)) = sk[1 - half][i]; *(LAS u32x4*)(kn + 16384 + v_off(skey0 + 32 * i, sch)) = sv[1 - half][i]; } }
            __syncthreads();
        } }
        };
        if (qh == 0) tile_loop(IntC<0>{}); else tile_loop(IntC<1>{});
#undef KV_FETCH
        const float inv = 1.0f / (lrun + __shfl_xor(lrun, 32));
        float ss = 0.f;
#pragma unroll
        for (int db = 0; db < 4; ++db)
#pragma unroll
            for (int i = 0; i < 16; ++i) { o[db][i] *= inv; ss += o[db][i] * o[db][i]; }
        ss += __shfl_xor(ss, 32);
        if (lane < 32) ssqo[(size_t)mq * NAH + head] = ss;
        {   LAS unsigned char* ost = lds + wave * 16384;
#pragma unroll
            for (int db = 0; db < 4; ++db)
#pragma unroll
                for (int g4 = 0; g4 < 4; ++g4) { const int d0 = 32 * db + 8 * g4 + 4 * h;
                    u32x2 w; w.x = pk2(o[db][4 * g4 + 0], o[db][4 * g4 + 1]); w.y = pk2(o[db][4 * g4 + 2], o[db][4 * g4 + 3]);
                    *(LAS u32x2*)(ost + rq * 272 + d0 * 2) = w; }
            bf16* obase = mixin + (size_t)(m0 + 64 * (wave >> 1) + 32 * qh) * D + head * 128;
            u32x4 orow[8];
#pragma unroll
            for (int i = 0; i < 8; ++i) { const int p = i * 64 + lane, row = p >> 4, ch = p & 15; orow[i] = *(const LAS u32x4*)(ost + row * 272 + ch * 16); }
            __builtin_amdgcn_sched_barrier(0);
#pragma unroll
            for (int i = 0; i < 8; ++i) { const int p = i * 64 + lane, row = p >> 4, ch = p & 15; *(u32x4*)(obase + (size_t)row * D + ch * 8) = orow[i]; }
        }
    }
}
#define MFMA16(a, b, c) __builtin_amdgcn_mfma_f32_16x16x32_bf16((a), (b), (c), 0, 0, 0)
constexpr int ACT_LD = 360;
constexpr int PP_OFF = 46080;
enum { PP_MUR0 = 0, PP_MUR1, PP_MUK0, PP_MUK1, PP_MUV0, PP_MUV1, PP_W00, PP_W01, PP_A00, PP_A01, PP_V0, PP_KK, PP_KA, PP_RK };
DI void phase_prep(CArgs& a, LAS unsigned char* lds, int l, int tid, int lane, int wave, int G) {
    const bf16* rcg = (const bf16*)(a.ws + WS_RBUF);
    const bf16* lb = (const bf16*)(a.ws + WS_LORA);
    LAS bf16* act = (LAS bf16*)lds;
    LAS float* prm = (LAS float*)(lds + PP_OFF);
    const bf16* lup = (const bf16*)(a.ws + WS_LUP) + (size_t)l * LUP_LAYER;
    unsigned short* o_r = (unsigned short*)(a.ws + WS_QKV); unsigned short* o_k = o_r + PLANE; unsigned short* o_v = o_k + PLANE;
    unsigned short* o_lw = (unsigned short*)(a.ws + WS_HB);
    unsigned short* o_a = (unsigned short*)(a.ws + WS_EX);
    unsigned short* o_g = (unsigned short*)(a.ws + WS_G);
    unsigned short* vfirst = (unsigned short*)(a.ws + WS_VFIRST);
    float* o_kn = (float*)(a.ws + WS_KN); float* o_bon = o_kn + (size_t)TOK * 16;
    const int fr = lane & 15, fq = lane >> 4;
    __syncthreads();
    {
        float pv[28];
#pragma unroll
        for (int k = 0; k < 28; ++k) { const int v = k >> 1, c = tid + 512 * (k & 1); float x;
            if (v < 6) x = a.in[I_MURKV][(size_t)(l * 3 + (v >> 1)) * 2048 + (v & 1) * 1024 + c];
            else if (v < 8) x = a.in[I_W0][(size_t)l * 2048 + (v - 6) * 1024 + c];
            else if (v < 10) x = a.in[I_A0][(size_t)l * 2048 + (v - 8) * 1024 + c];
            else if (v == 10) x = a.in[I_V0][(size_t)max(l - 1, 0) * 1024 + c];
            else if (v == 11) x = a.in[I_KK][(size_t)l * 1024 + c];
            else if (v == 12) x = a.in[I_KA][(size_t)l * 1024 + c];
            else x = a.in[I_RK][(size_t)l * 1024 + c];
            pv[k] = x; }
        __builtin_amdgcn_sched_barrier(0);
#pragma unroll
        for (int k = 0; k < 28; ++k) { const int v = k >> 1, c = tid + 512 * (k & 1); prm[v * 1024 + c] = (v == 10 && l == 0) ? 0.f : pv[k]; }
    }
    for (int tile = blockIdx.x; tile < TOK / 32; tile += G) {
        const int m0 = tile * 32; int s, t0, T; tokinfo(m0, s, t0, T);
        __syncthreads();
        {
            u32x4 aw[3], awp[3], awn[3];
#pragma unroll
            for (int k = 0; k < 3; ++k) { const int it = min(tid + 512 * k, 32 * 44 - 1), i = it / 44, c = 8 * (it % 44), m = m0 + i, t = t0 + i;
                const bf16* p0 = lb + (size_t)m * NLB + c;
                aw[k] = *(const u32x4*)p0; awp[k] = *(const u32x4*)(p0 + (t > 0 ? -NLB : 0) + LORA); awn[k] = *(const u32x4*)(p0 + (t < T - 1 ? NLB : 0) + 2 * LORA); }
            __builtin_amdgcn_sched_barrier(0);
#pragma unroll
            for (int k = 0; k < 3; ++k) { const int it = tid + 512 * k; if (it < 32 * 44) { const int i = it / 44, c = 8 * (it % 44), t = t0 + i;
                const u32x4 w = aw[k], wp = awp[k], wn = awn[k];
                const float pm = t > 0 ? 1.f : 0.f, nm = t < T - 1 ? 1.f : 0.f;
                float v[8];
#pragma unroll
                for (int j = 0; j < 4; ++j) { v[2 * j] = bflo(w[j]) + pm * bflo(wp[j]) + nm * bflo(wn[j]); v[2 * j + 1] = bfhi(w[j]) + pm * bfhi(wp[j]) + nm * bfhi(wn[j]); }
                if (c < 128) {
#pragma unroll
                    for (int j = 0; j < 8; ++j) v[j] = tanhf_(v[j]); }
                else if (c >= 256 && c < 320) {
#pragma unroll
                    for (int j = 0; j < 8; ++j) v[j] = sigmoidf_(v[j]); }
                u32x4 ow; ow.x = pkbf(v[0], v[1]); ow.y = pkbf(v[2], v[3]); ow.z = pkbf(v[4], v[5]); ow.w = pkbf(v[6], v[7]);
                *(LAS u32x4*)(act + i * ACT_LD + c) = ow; } }
        }
        __syncthreads();
        LAS float* hpart = (LAS float*)(lds + PP_OFF + 57344) + wave * 192;
#pragma unroll 1
        for (int hc = 0; hc < 4; ++hc) {
            const int hp = hc >> 1, cgl = hc & 1, cg = hc;
            const int cbase = 128 * wave + 32 * cg, c0 = cbase + 8 * fq;
            const int wrow0 = cbase + 8 * (fr >> 2) + (fr & 3);
            bf16x8 wf[6][2][2];
#pragma unroll
            for (int mm = 0; mm < 6; ++mm) { const bf16* wt = lup + (mm < 2 ? LUP_W2 + mm * 65536 : mm < 4 ? LUP_A2 + (mm - 2) * 65536 : mm == 4 ? LUP_G2 : LUP_V2); const int kw = (mm == 5) ? 32 : 64;
#pragma unroll
                for (int ks = 0; ks < (mm == 5 ? 1 : 2); ++ks)
#pragma unroll
                    for (int n = 0; n < 2; ++n) wf[mm][ks][n] = *(const bf16x8*)(wt + (size_t)(wrow0 + 4 * n) * kw + 32 * ks + 8 * fq); }
#pragma unroll 1
            for (int tb = 0; tb < 2; ++tb) {
            const int i = 16 * tb + fr, m = m0 + i, t = t0 + i;
            u32x4 cur[10];
            const size_t ob = ((size_t)(4 * wave + cg) * TOK + m) * 32 + 8 * fq;
            {   const bf16* rp_ = rcg + ob; const int tp_ = t > 0 ? -32 : 0, tn_ = t < T - 1 ? 32 : 0;
                cur[0] = *(const u32x4*)rp_; cur[1] = *(const u32x4*)(rp_ + PLANE); cur[2] = *(const u32x4*)(rp_ + 2 * PLANE);
                cur[3] = *(const u32x4*)(rp_ + tp_); cur[4] = *(const u32x4*)(rp_ + tp_ + PLANE); cur[5] = *(const u32x4*)(rp_ + tp_ + 2 * PLANE);
                cur[6] = *(const u32x4*)(rp_ + tn_); cur[7] = *(const u32x4*)(rp_ + tn_ + PLANE); cur[8] = *(const u32x4*)(rp_ + tn_ + 2 * PLANE);
                cur[9] = l > 0 ? __builtin_nontemporal_load((const u32x4*)(vfirst + ob)) : (u32x4){0u, 0u, 0u, 0u}; }
            float pss = 0.f, pb0 = 0.f, pb1 = 0.f;
            const LAS bf16* arow = act + i * ACT_LD + 8 * fq;
#define LUP(name, mm) f32x4 name[2] = {(f32x4){0.f, 0.f, 0.f, 0.f}, (f32x4){0.f, 0.f, 0.f, 0.f}}; { _Pragma("unroll") for (int ks_ = 0; ks_ < ((mm) == 5 ? 1 : 2); ++ks_) { const bf16x8 af_ = *(const LAS bf16x8*)(arow + 64 * (mm) + 32 * ks_); \
                _Pragma("unroll") for (int n_ = 0; n_ < 2; ++n_) name[n_] = MFMA16(wf[mm][ks_][n_], af_, name[n_]); } }
            const LAS float* pp = prm + c0;
#define PRM8(name, vi_) float name[8]; { const f32x4 x0_ = *(const LAS f32x4*)(pp + (vi_) * 1024), x1_ = *(const LAS f32x4*)(pp + (vi_) * 1024 + 4); \
                name[0] = x0_[0]; name[1] = x0_[1]; name[2] = x0_[2]; name[3] = x0_[3]; name[4] = x1_[0]; name[5] = x1_[1]; name[6] = x1_[2]; name[7] = x1_[3]; }
#define BF8(dst, src, msk) float dst[8]; { _Pragma("unroll") for (int j_ = 0; j_ < 4; ++j_) { dst[2 * j_] = (msk) * bflo(src[j_]); dst[2 * j_ + 1] = (msk) * bfhi(src[j_]); } }
#define ST8H(ptr, arr_) do { u32x4 w_; w_[0] = pkh2(arr_[0], arr_[1]); w_[1] = pkh2(arr_[2], arr_[3]); w_[2] = pkh2(arr_[4], arr_[5]); w_[3] = pkh2(arr_[6], arr_[7]); __builtin_nontemporal_store(w_, (u32x4*)(ptr)); } while (0)
            const float pm = t > 0 ? 1.f : 0.f, nm = t < T - 1 ? 1.f : 0.f;
            float rr[8], kk[8];
            {   PRM8(m0_, PP_MUR0) PRM8(m1_, PP_MUR1) BF8(c_, cur[0], 1.f) BF8(p_, cur[3], pm) BF8(n_, cur[6], nm)
#pragma unroll
                for (int j = 0; j < 8; ++j) rr[j] = c_[j] + m0_[j] * (p_[j] - c_[j]) + m1_[j] * (n_[j] - c_[j]);
                ST8H(o_r + ob, rr); }
            {   PRM8(m0_, PP_MUK0) PRM8(m1_, PP_MUK1) BF8(c_, cur[1], 1.f) BF8(p_, cur[4], pm) BF8(n_, cur[7], nm)
#pragma unroll
                for (int j = 0; j < 8; ++j) kk[j] = c_[j] + m0_[j] * (p_[j] - c_[j]) + m1_[j] * (n_[j] - c_[j]);
                ST8H(o_k + ob, kk); }
            {   float vv[8]; PRM8(m0_, PP_MUV0) PRM8(m1_, PP_MUV1) BF8(c_, cur[2], 1.f) BF8(p_, cur[5], pm) BF8(n_, cur[8], nm)
#pragma unroll
                for (int j = 0; j < 8; ++j) vv[j] = c_[j] + m0_[j] * (p_[j] - c_[j]) + m1_[j] * (n_[j] - c_[j]);
                if (l == 0) { ST8H(vfirst + ob, vv); }
                else { PRM8(v0_, PP_V0) LUP(accv, 5)
#pragma unroll
                    for (int j = 0; j < 8; ++j) { const float f = (j & 1) ? hhi(cur[9][j >> 1]) : hlo(cur[9][j >> 1]); const float gte = sigmoidf_(v0_[j] + accv[j >> 2][j & 3]); vv[j] = vv[j] + (f - vv[j]) * gte; } }
                ST8H(o_v + ob, vv); }
            {   PRM8(ka_, PP_KA) PRM8(rk_, PP_RK)
#pragma unroll
                for (int d = 0; d < 2; ++d) { float lw[8], av[8]; PRM8(w0_, PP_W00 + d) PRM8(a0_, PP_A00 + d) LUP(accw, d) LUP(acca, 2 + d)
#pragma unroll
                    for (int j = 0; j < 8; ++j) { lw[j] = -0.6065306597126334f * sigmoidf_(w0_[j] + accw[j >> 2][j & 3]); av[j] = sigmoidf_(a0_[j] + acca[j >> 2][j & 3]);
                        const float pbv = rr[j] * (kk[j] * (1.0f + (av[j] - 1.0f) * ka_[j])) * rk_[j]; if (d == 0) pb0 += pbv; else pb1 += pbv; }
                    ST8H(o_lw + (size_t)d * PLANE + ob, lw); ST8H(o_a + (size_t)d * PLANE + ob, av); } }
            { LUP(accg, 4) u32x4 w; w.x = pkh2(accg[0][0], accg[0][1]); w.y = pkh2(accg[0][2], accg[0][3]); w.z = pkh2(accg[1][0], accg[1][1]); w.w = pkh2(accg[1][2], accg[1][3]);
              __builtin_nontemporal_store(w, (u32x4*)(o_g + ob)); }
            {   PRM8(kkp_, PP_KK)
#pragma unroll
                for (int j = 0; j < 8; ++j) { const float x = kk[j] * kkp_[j]; pss += x * x; } }
#undef PRM8
#undef BF8
#undef ST8H
#undef LUP
            {   float q0 = pss, q1 = pb0, q2 = pb1;
                q0 += __shfl_xor(q0, 16); q0 += __shfl_xor(q0, 32); q1 += __shfl_xor(q1, 16); q1 += __shfl_xor(q1, 32); q2 += __shfl_xor(q2, 16); q2 += __shfl_xor(q2, 32);
                LAS float* hq = hpart + (tb * 16 + fr) * 3;
                if (cgl == 0) { if (lane < 16) { hq[0] = q0; hq[1] = q1; hq[2] = q2; } }
                else if (lane < 16) { q0 += hq[0]; q1 += hq[1]; q2 += hq[2];
                    const size_t o = (size_t)m * 16 + 2 * wave + hp; o_kn[o] = __builtin_amdgcn_rsqf(fmaxf(q0, 1e-24f)); o_bon[o] = q1; o_bon[(size_t)TOK * 16 + o] = q2; } }
            }
        }
    }
}

constexpr int NAT_LD = 144, NAT_ARR = 32 * NAT_LD, CHM_LD = 80, CHM_ARR = 64 * CHM_LD;
constexpr int NAT_ALL = 4 * NAT_ARR, CHM_ALL = 4 * CHM_ARR, NC_BUF = NAT_ALL + CHM_ALL;
constexpr int O_RAW = 0, O_BUF = 20480;
template <int DB> struct SlotMap { static constexpr int O_SM = O_BUF + DB * NC_BUF, O_FLAG = O_SM + DB * 512, BYTES = O_FLAG + 64; };
constexpr int SLOT0 = SlotMap<2>::BYTES, SLOT1 = SlotMap<1>::BYTES;
enum { F_RAW = 0, F_ST0 = 1, F_ST1 = 2, F_CONS = 3 };
DI bf16x8 packc(const f32x16& x, int s) { u32x4 p; p.x = pkbf(x[8 * s + 0], x[8 * s + 1]); p.y = pkbf(x[8 * s + 2], x[8 * s + 3]); p.z = pkbf(x[8 * s + 4], x[8 * s + 5]); p.w = pkbf(x[8 * s + 6], x[8 * s + 7]); return __builtin_bit_cast(bf16x8, p); }
DI void spin_ge(volatile LAS unsigned* f, unsigned v) { unsigned sp = 0; while (*f < v && ++sp < (1u << 24)) __builtin_amdgcn_s_sleep(1); asm volatile("" ::: "memory"); }
DI bf16x8 ld_perm(const LAS unsigned char* row, int s, int h) {
    const s16x4 lo = *(const LAS s16x4*)(row + 2 * (16 * s + 4 * h)), hi = *(const LAS s16x4*)(row + 2 * (16 * s + 8 + 4 * h));
    return __builtin_shufflevector(lo, hi, 0, 1, 2, 3, 4, 5, 6, 7);
}
DI void scan_dma(const unsigned short* const (&src)[5], LAS unsigned char* raw, size_t tokoff, int d, int lane) {
    int tl = lane >> 3, pc = (lane & 7) * 8; asm volatile("" : "+v"(tl), "+v"(pc));
#pragma unroll
    for (int rg = 0; rg < 4; ++rg) { const int R = 8 * rg + tl; const size_t lo = ((size_t)(pc >> 5) * TOK + tokoff + (size_t)(d ? 31 - R : R)) * 32 + (pc & 31);
#pragma unroll
        for (int arr = 0; arr < 5; ++arr)
            __builtin_amdgcn_global_load_lds((const unsigned*)(src[arr] + lo), (LAS unsigned*)(raw + (arr * 32 + rg * 8) * 128), 16, 0, 0); }
}
DI float scan_stage(const LAS unsigned char* raw, LAS unsigned char* nat, LAS unsigned char* chm, const LAS float* kns, int lane, int o0, int o1, float E, float kkc, float kac) {
    const LAS unsigned short* rw = (const LAS unsigned short*)raw + lane;
#pragma unroll 1
    for (int o = o0; o < o1; ++o) {
        const LAS unsigned short* ro = rw + (8 * o) * 64;
        unsigned short xr[8], xk[8], xv[8], xl[8], xa[8];
#pragma unroll
        for (int e8 = 0; e8 < 8; ++e8) { xr[e8] = ro[(0 * 32 + e8) * 64]; xk[e8] = ro[(1 * 32 + e8) * 64]; xv[e8] = ro[(2 * 32 + e8) * 64]; xl[e8] = ro[(3 * 32 + e8) * 64]; xa[e8] = ro[(4 * 32 + e8) * 64]; }
        const f32x4 kn0 = *(const LAS f32x4*)(kns + 8 * o), kn1 = *(const LAS f32x4*)(kns + 8 * o + 4);
        __builtin_amdgcn_sched_barrier(0);
        unsigned pa[4][4];
        float ha[4] = {0.f, 0.f, 0.f, 0.f};
        LAS unsigned short* npo = (LAS unsigned short*)(nat + (8 * o) * NAT_LD) + lane;
#pragma unroll
        for (int e8 = 0; e8 < 8; ++e8) {
            const float r = h2f(xr[e8]), k = h2f(xk[e8]), v = h2f(xv[e8]), lw = h2f(xl[e8]), av = h2f(xa[e8]);
            const float Ep = E; E = E * __expf(lw); const float iE = __builtin_amdgcn_rcpf(E);
            const float kkn = k * kkc * (e8 < 4 ? kn0[e8 & 3] : kn1[e8 & 3]);
            const float kd = k * (1.0f + (av - 1.0f) * kac);
            const float bvec = kkn * av, at = -kkn * Ep, bh = bvec * iE, kh = kd * iE, rt = r * E;
            const unsigned w01 = pkbf(bh, kh), w23 = pkbf(at, rt);
            LAS unsigned short* np_ = npo + e8 * (NAT_LD / 2);
            np_[0] = (unsigned short)w01; np_[NAT_ARR / 2] = (unsigned short)(w01 >> 16); np_[2 * (NAT_ARR / 2)] = (unsigned short)w23; np_[3 * (NAT_ARR / 2)] = (unsigned short)(w23 >> 16);
            if ((e8 & 1) == 0) { ha[0] = at; ha[1] = v; ha[2] = bh; ha[3] = kh; }
            else { pa[0][e8 >> 1] = pkbf(ha[0], at); pa[1][e8 >> 1] = pkbf(ha[1], v); pa[2][e8 >> 1] = pkbf(ha[2], bh); pa[3][e8 >> 1] = pkbf(ha[3], kh); }
        }
#pragma unroll
        for (int ar = 0; ar < 4; ++ar) *(LAS u32x4*)(chm + ar * CHM_ARR + lane * CHM_LD + 16 * o) = (u32x4){pa[ar][0], pa[ar][1], pa[ar][2], pa[ar][3]};
    }
    return E;
}
DI void scan_decode(int unit, int& s, int& hh, int& d) { if (unit < 256) { s = unit >> 5; hh = (unit >> 1) & 15; d = unit & 1; } else { const int uu = unit - 256; s = 8 + (uu >> 5); hh = (uu >> 1) & 15; d = uu & 1; } }
template <int DB> DI void scan_helper(CArgs& a, LAS unsigned char* sm, int l, int unit, int lane, int hsel) {
    int s, hh, d; scan_decode(unit, s, hh, d);
    const int T = seq_len(s), mbase = seq_start(s), ch = hh * 64 + lane, nchunk = T >> 5;
    const unsigned short* i_r = (const unsigned short*)(a.ws + WS_QKV);
    const unsigned short* const src[5] = {i_r, i_r + PLANE, i_r + 2 * PLANE, (const unsigned short*)(a.ws + WS_HB) + (size_t)d * PLANE, (const unsigned short*)(a.ws + WS_EX) + (size_t)d * PLANE};
    const float* g_kn = (const float*)(a.ws + WS_KN) + hh; const float* g_bon = g_kn + (size_t)(1 + d) * TOK * 16;
    const float kkc = a.in[I_KK][l * 1024 + ch], kac = a.in[I_KA][l * 1024 + ch];
    asm volatile("" : "+s"(sm));
    LAS unsigned char* raw = sm + O_RAW;
    volatile LAS unsigned* flg = (volatile LAS unsigned*)(sm + SlotMap<DB>::O_FLAG);
    float knv = 0.f, bnv = 0.f;
    if (hsel == 0) { scan_dma(src, raw, (size_t)2 * hh * TOK + (size_t)(mbase + (d ? T - 32 : 0)), d, lane);
        const size_t o = (size_t)(mbase + (d ? T - 1 - (lane & 31) : (lane & 31))) * 16; knv = g_kn[o]; bnv = g_bon[o];
        asm volatile("s_waitcnt vmcnt(0)" ::: "memory"); }
#pragma unroll 1
    for (int n = 0; n < nchunk; ++n) {
        const int b = (DB == 2) ? (n & 1) : 0;
        LAS unsigned char* nat = sm + O_BUF + b * NC_BUF; LAS unsigned char* chm = nat + NAT_ALL;
        LAS float* ecv = (LAS float*)(sm + SlotMap<DB>::O_SM + b * 512); LAS float* bon = ecv + 64; LAS float* kns = ecv + 96;
        if (hsel == 0) {
            if (n + 1 > DB) spin_ge(flg + F_CONS, (unsigned)(n + 1 - DB));
            { int ln = lane; asm volatile("" : "+v"(ln)); if (ln < 32) { kns[ln] = knv; bon[ln] = bnv; } }
            asm volatile("s_waitcnt lgkmcnt(0)" ::: "memory");
            if (lane == 0) flg[F_RAW] = (unsigned)(n + 1);
            (void)scan_stage(raw, nat, chm, kns, lane, 0, 2, 1.0f, kkc, kac);
            asm volatile("s_waitcnt lgkmcnt(0)" ::: "memory");
            if (lane == 0) flg[F_ST0] = (unsigned)(n + 1);
            spin_ge(flg + F_ST1, (unsigned)(n + 1));
            if (n + 1 < nchunk) { scan_dma(src, raw, (size_t)2 * hh * TOK + (size_t)(mbase + (d ? T - 32 * (n + 2) : 32 * (n + 1))), d, lane);
                const size_t o = (size_t)(mbase + (d ? T - 32 * (n + 1) - 1 - (lane & 31) : 32 * (n + 1) + (lane & 31))) * 16; knv = g_kn[o]; bnv = g_bon[o];
                asm volatile("s_waitcnt vmcnt(0)" ::: "memory"); }
        } else {
            spin_ge(flg + F_RAW, (unsigned)(n + 1));
            const LAS unsigned short* rw = (const LAS unsigned short*)raw + lane;
            float lam = 0.f; unsigned short xl[16];
#pragma unroll
            for (int t = 0; t < 16; ++t) xl[t] = rw[(3 * 32 + t) * 64];
#pragma unroll
            for (int t = 0; t < 16; ++t) lam += h2f(xl[t]);
            const float E = scan_stage(raw, nat, chm, kns, lane, 2, 4, __expf(lam), kkc, kac);
            ecv[lane] = E;
            asm volatile("s_waitcnt lgkmcnt(0)" ::: "memory");
            if (lane == 0) flg[F_ST1] = (unsigned)(n + 1);
        }
    }
}
#define ZERO16(x) do { _Pragma("unroll") for (int _i = 0; _i < 16; ++_i) (x)[_i] = 0.f; } while (0)
template <int DB> DI void scan_unit(CArgs& a, LAS unsigned char* sm, int l, int unit, int lane) {
    int s, hh, d; scan_decode(unit, s, hh, d);
    const int T = seq_len(s), mbase = seq_start(s), nchunk = T >> 5;
    unsigned short* yout = (unsigned short*)(a.ws + WS_RBUF) + (size_t)d * PLANE;
    asm volatile("" : "+s"(sm));
    volatile LAS unsigned* flg = (volatile LAS unsigned*)(sm + SlotMap<DB>::O_FLAG);
    f32x16 ST[2][2];
#pragma unroll
    for (int x = 0; x < 2; ++x)
#pragma unroll
        for (int y = 0; y < 2; ++y) ZERO16(ST[x][y]);
#pragma unroll 1
    for (int c = 0; c < nchunk; ++c) {
        const int tok0 = d ? T - 32 * (c + 1) : 32 * c;
        const int b = (DB == 2) ? (c & 1) : 0;
        const LAS unsigned char* nat = sm + O_BUF + b * NC_BUF; const LAS unsigned char* chm = nat + NAT_ALL;
        const LAS float* ecv = (const LAS float*)(sm + SlotMap<DB>::O_SM + b * 512); const LAS float* bon = ecv + 64;
        spin_ge(flg + F_ST0, (unsigned)(c + 1)); spin_ge(flg + F_ST1, (unsigned)(c + 1));
        int lq = lane; asm volatile("" : "+v"(lq)); const int rq = lq & 31, h = lq >> 5;
        const LAS unsigned char* natr = nat + rq * NAT_LD + 16 * h;
#define NATF(arr, ks) (*(const LAS bf16x8*)(natr + (arr) * NAT_ARR + 32 * (ks)))
#define CHMROW(arr, blk) (chm + (arr) * CHM_ARR + (32 * (blk) + rq) * CHM_LD)
#define CHMF(arr, blk, ks) (*(const LAS bf16x8*)(CHMROW(arr, blk) + 32 * (ks) + 16 * h))
        f32x16 Tm, UakT, Wrb, Wrk;
        ZERO16(UakT); ZERO16(Wrb); ZERO16(Wrk);
        {
            f32x16 Nm, NT, TT;
            ZERO16(Nm); ZERO16(NT);
#pragma unroll
            for (int ks = 0; ks < 4; ++ks) { const bf16x8 fb = NATF(0, ks), fa = NATF(2, ks); Nm = MFMA32(fb, fa, Nm); NT = MFMA32(fa, fb, NT); }
#pragma unroll
            for (int i = 0; i < 16; ++i) { const int row = (i & 3) + 8 * (i >> 2) + 4 * h; Nm[i] = row < rq ? Nm[i] : 0.f; NT[i] = rq < row ? NT[i] : 0.f; Tm[i] = Nm[i] + (row == rq ? 1.f : 0.f); TT[i] = NT[i] + (row == rq ? 1.f : 0.f); }
#pragma unroll
            for (int st = 0; st < 4; ++st) {
                const bf16x8 pN0 = packc(Nm, 0), pN1 = packc(Nm, 1), pT0 = packc(NT, 0), pT1 = packc(NT, 1);
                f32x16 N2; ZERO16(N2); N2 = MFMA32(pT0, pN0, N2); N2 = MFMA32(pT1, pN1, N2);
                f32x16 N2T; ZERO16(N2T);
                if (st < 3) { N2T = MFMA32(pN0, pT0, N2T); N2T = MFMA32(pN1, pT1, N2T); }
                { const bf16x8 fb = NATF(0, st), fk = NATF(1, st), fa = NATF(2, st), fr = NATF(3, st);
                  UakT = MFMA32(fa, fk, UakT); Wrb = MFMA32(fb, fr, Wrb); Wrk = MFMA32(fk, fr, Wrk); }
                const bf16x8 pM0 = packc(N2, 0), pM1 = packc(N2, 1), pU0 = packc(TT, 0), pU1 = packc(TT, 1);
                Tm = MFMA32(pU0, pM0, Tm); Tm = MFMA32(pU1, pM1, Tm);
                if (st < 3) { TT = MFMA32(pM0, pU0, TT); TT = MFMA32(pM1, pU1, TT); Nm = N2; NT = N2T; }
            }
        }
        f32x16 Z[2];
        {   f32x16 X, P[2];
            const float bnc = bon[rq];
#pragma unroll
            for (int i = 0; i < 16; ++i) { const int row = (i & 3) + 8 * (i >> 2) + 4 * h; UakT[i] = rq < row ? UakT[i] : 0.f; Wrb[i] = row <= rq ? Wrb[i] : 0.f; Wrk[i] = row <= rq ? Wrk[i] : 0.f; if (row == rq) Wrk[i] += bnc; }
            const bf16x8 pT0 = packc(Tm, 0), pT1 = packc(Tm, 1);
            ZERO16(X); X = MFMA32(packc(UakT, 0), pT0, X); X = MFMA32(packc(UakT, 1), pT1, X);
            const bf16x8 pX0 = packc(X, 0), pX1 = packc(X, 1);
#pragma unroll
            for (int b2 = 0; b2 < 2; ++b2) { ZERO16(P[b2]); ZERO16(Z[b2]);
                P[b2] = MFMA32(ld_perm(CHMROW(0, b2), 0, h), pT0, P[b2]); P[b2] = MFMA32(ld_perm(CHMROW(0, b2), 1, h), pT1, P[b2]);
                Z[b2] = MFMA32(pX0, ld_perm(CHMROW(1, b2), 0, h), Z[b2]); Z[b2] = MFMA32(pX1, ld_perm(CHMROW(1, b2), 1, h), Z[b2]); }
#pragma unroll
            for (int jb = 0; jb < 2; ++jb) { const bf16x8 p0 = packc(P[jb], 0), p1 = packc(P[jb], 1);
#pragma unroll
                for (int ib = 0; ib < 2; ++ib) { Z[ib] = MFMA32(p0, packc(ST[jb][ib], 0), Z[ib]); Z[ib] = MFMA32(p1, packc(ST[jb][ib], 1), Z[ib]); } }
        }
        {   f32x16 Y[2];
            const bf16x8 pK0 = packc(Wrk, 0), pK1 = packc(Wrk, 1), pW0 = packc(Wrb, 0), pW1 = packc(Wrb, 1);
            const LAS unsigned char* rrow = nat + 3 * NAT_ARR + rq * NAT_LD;
#pragma unroll
            for (int ib = 0; ib < 2; ++ib) { ZERO16(Y[ib]);
                Y[ib] = MFMA32(pK0, ld_perm(CHMROW(1, ib), 0, h), Y[ib]); Y[ib] = MFMA32(pK1, ld_perm(CHMROW(1, ib), 1, h), Y[ib]);
                Y[ib] = MFMA32(pW0, packc(Z[ib], 0), Y[ib]); Y[ib] = MFMA32(pW1, packc(Z[ib], 1), Y[ib]);
#pragma unroll
                for (int jb = 0; jb < 2; ++jb) { Y[ib] = MFMA32(ld_perm(rrow + 64 * jb, 0, h), packc(ST[jb][ib], 0), Y[ib]); Y[ib] = MFMA32(ld_perm(rrow + 64 * jb, 1, h), packc(ST[jb][ib], 1), Y[ib]); } }
#pragma unroll
            for (int ib = 0; ib < 2; ++ib)
#pragma unroll
                for (int i = 0; i < 16; ++i) { const int tau = (i & 3) + 8 * (i >> 2) + 4 * h; const int tok = tok0 + (d ? 31 - tau : tau);
                    yout[(size_t)(mbase + tok) * 1024 + hh * 64 + 32 * ib + rq] = (unsigned short)pkbf(Y[ib][i], 0.f); }
        }
        {
#pragma unroll
            for (int ib = 0; ib < 2; ++ib) { const bf16x8 pZ0 = packc(Z[ib], 0), pZ1 = packc(Z[ib], 1);
#pragma unroll
                for (int jc = 0; jc < 2; ++jc) {
                    ST[jc][ib] = MFMA32(ld_perm(CHMROW(2, jc), 0, h), pZ0, ST[jc][ib]); ST[jc][ib] = MFMA32(ld_perm(CHMROW(2, jc), 1, h), pZ1, ST[jc][ib]);
                    ST[jc][ib] = MFMA32(CHMF(3, jc, 0), CHMF(1, ib, 0), ST[jc][ib]); ST[jc][ib] = MFMA32(CHMF(3, jc, 1), CHMF(1, ib, 1), ST[jc][ib]); } }
#pragma unroll
            for (int jc = 0; jc < 2; ++jc)
#pragma unroll
                for (int g4 = 0; g4 < 4; ++g4) { const f32x4 e = *(const LAS f32x4*)(ecv + 32 * jc + 8 * g4 + 4 * h);
#pragma unroll
                    for (int ib = 0; ib < 2; ++ib) { ST[jc][ib][4 * g4 + 0] *= e.x; ST[jc][ib][4 * g4 + 1] *= e.y; ST[jc][ib][4 * g4 + 2] *= e.z; ST[jc][ib][4 * g4 + 3] *= e.w; } }
        }
#undef NATF
#undef CHMROW
#undef CHMF
        asm volatile("s_waitcnt lgkmcnt(0)" ::: "memory");
        if (lane == 0) flg[F_CONS] = (unsigned)(c + 1);
    }
}
DI void phase_scan(CArgs& a, LAS unsigned char* lds, int l, int lane, int wave, int G) {
    LAS unsigned char* sm1 = lds + SLOT0;
    if (wave == 0 && lane < 16) ((LAS unsigned*)(lds + SlotMap<2>::O_FLAG))[lane] = 0u;
    if (wave == 1 && lane < 16) ((LAS unsigned*)(sm1 + SlotMap<1>::O_FLAG))[lane] = 0u;
    __syncthreads();
    const bool has1 = blockIdx.x < 128;
    const int nbg = G + (G - 128) * 3;
    if (wave == 0) scan_unit<2>(a, lds, l, blockIdx.x, lane);
    else if (wave == 2) scan_helper<2>(a, lds, l, blockIdx.x, lane, 0);
    else if (wave == 3) scan_helper<2>(a, lds, l, blockIdx.x, lane, 1);
    else if (wave == 4) { }
    else if (wave == 5) background_weights(a, l, (LAS float*)(lds + SLOT0 + SLOT1), blockIdx.x, nbg, lane);
    else if (has1) { if (wave == 1) scan_unit<1>(a, sm1, l, 256 + blockIdx.x, lane); else if (wave == 6) scan_helper<1>(a, sm1, l, 256 + blockIdx.x, lane, 0); else scan_helper<1>(a, sm1, l, 256 + blockIdx.x, lane, 1); }
    else { const int q = wave == 1 ? 0 : wave == 6 ? 1 : 2; background_weights(a, l, (LAS float*)(sm1 + q * 4224), G + (blockIdx.x - 128) * 3 + q, nbg, lane); }
}


DI void phase_post(CArgs& a, int l, int lane, int wave, int G) {
    const unsigned short* y0 = (const unsigned short*)(a.ws + WS_RBUF); const unsigned short* y1 = y0 + PLANE;
    unsigned short* mx = (unsigned short*)(a.ws + WS_MIXIN);
    const unsigned short* gbuf = (const unsigned short*)(a.ws + WS_G) + (size_t)(lane >> 3) * TOK * 32 + 4 * (lane & 7);
    const float* ssq = (const float*)(a.ws + WS_SSQ);
    f32x4 lnw[4], lnb[4];
#pragma unroll
    for (int j = 0; j < 4; ++j) { const int c = 4 * (lane + 64 * j); lnw[j] = *(const f32x4*)(a.in[I_LNW] + l * 1024 + c); lnb[j] = *(const f32x4*)(a.in[I_LNB] + l * 1024 + c); }
    u32x2 ny0[4], ny1[4]; f32x4 ns0, ns1; u32x2 ng[4];
#define POST_LOAD(mm_) do { _Pragma("unroll") for (int j = 0; j < 4; ++j) { ny0[j] = __builtin_nontemporal_load((const u32x2*)(y0 + (size_t)(mm_) * 1024) + lane + 64 * j); ny1[j] = __builtin_nontemporal_load((const u32x2*)(y1 + (size_t)(mm_) * 1024) + lane + 64 * j); \
            ng[j] = __builtin_nontemporal_load((const u32x2*)(gbuf + ((size_t)8 * j * TOK + (mm_)) * 32)); } \
            ns0 = *(const f32x4*)(ssq + (size_t)(mm_) * 8); ns1 = *(const f32x4*)(ssq + (size_t)(mm_) * 8 + 4); } while (0)
    int m = blockIdx.x * 8 + wave;
    if (m < TOK) POST_LOAD(m);
#pragma unroll 1
    for (; m < TOK; m += G * 8) {
        f32x4 y[4]; u32x2 g[4]; const f32x4 s0 = ns0, s1 = ns1;
#pragma unroll
        for (int j = 0; j < 4; ++j) { y[j] = (f32x4){bflo(ny0[j].x) + bflo(ny1[j].x), bfhi(ny0[j].x) + bfhi(ny1[j].x), bflo(ny0[j].y) + bflo(ny1[j].y), bfhi(ny0[j].y) + bfhi(ny1[j].y)}; g[j] = ng[j]; }
        if (m + G * 8 < TOK) POST_LOAD(m + G * 8);
        const float irs = __builtin_sqrtf(((s0.x + s0.y) + (s0.z + s0.w) + (s1.x + s1.y) + (s1.z + s1.w)) * (1.0f / 1024.0f) + NORM_EPS);
#pragma unroll
        for (int j = 0; j < 4; ++j) {
            float sum = (y[j].x + y[j].y) + (y[j].z + y[j].w);
            sum = DPP_ROR_ADD(sum, 8); sum = DPP_ROR_ADD(sum, 4); sum = DPP_ROR_ADD(sum, 2); sum = DPP_ROR_ADD(sum, 1);
            const float mean = sum * (1.0f / 64.0f);
            const f32x4 dv = y[j] - mean;
            float sq = (dv.x * dv.x + dv.y * dv.y) + (dv.z * dv.z + dv.w * dv.w);
            sq = DPP_ROR_ADD(sq, 8); sq = DPP_ROR_ADD(sq, 4); sq = DPP_ROR_ADD(sq, 2); sq = DPP_ROR_ADD(sq, 1);
            const float rstd = __builtin_amdgcn_rsqf(sq * (1.0f / 64.0f) + GN_EPS);
            const f32x4 o = (dv * rstd * lnw[j] + lnb[j]) * ((f32x4){hlo(g[j].x), hhi(g[j].x), hlo(g[j].y), hhi(g[j].y)} * irs);
            u32x2 w; w.x = pk2(o.x, o.y); w.y = pk2(o.z, o.w);
            ((u32x2*)(mx + (size_t)m * D + 1024))[lane + 64 * j] = w; }
    }
#undef POST_LOAD
}
constexpr int NPHASE = 2 + 10 * DEPTH;
__global__ void __launch_bounds__(512, 2) hymba_fwd(Args args) {
    extern __shared__ __attribute__((aligned(16))) unsigned char lds_raw[];
    LAS unsigned char* lds = (LAS unsigned char*)lds_raw;
    const int G = gridDim.x;
    const int wave_sgpr = __builtin_amdgcn_readfirstlane(threadIdx.x >> 6);
    if (threadIdx.x < 64) ((LAS unsigned*)(lds + L_MISC))[threadIdx.x] = 0u;
    __syncthreads();
    const int lo = args.ph_lo, hi = args.ph_hi;
    XcdBarrier bar; bar.bar = (unsigned*)(args.ws + WS_CTL) + CW_BAR; bar.x = 0; bar.st = nullptr;
    if (hi - lo > 1) bar = xcd_barrier_post((unsigned*)(args.ws + WS_CTL) + CW_BAR, (volatile LAS unsigned*)(lds + L_MISC));
#define PH(k) (lo <= (k) && (k) < hi)
#define LANE_IDS CArgs* ap_ = (CArgs*)__builtin_amdgcn_kernarg_segment_ptr(); asm volatile("" : "+s"(ap_)); CArgs& A = *ap_; unsigned z_; asm volatile("v_mov_b32 %0, 0" : "=v"(z_)); const int tid = wave_sgpr * 64 + (int)__builtin_amdgcn_mbcnt_hi(~0u, __builtin_amdgcn_mbcnt_lo(~0u, z_)); const int lane = tid & 63, wave = __builtin_amdgcn_readfirstlane(tid >> 6); (void)lane; (void)wave
#define SEAM(k) do { if (PH(k) && PH((k) + 1)) { xcd_barrier(bar); if (MK_PROBE_REP == 100) xcd_barrier(bar); } } while (0)
#ifndef MK_PROBE_REP
#define MK_PROBE_REP -1
#endif
#define NREP(k) ((MK_PROBE_REP == (k)) ? 2 : 1)
    if (PH(0)) { LANE_IDS; phase_prologue(A, lds, tid, lane, wave, G); }
#if MK_PROBE_REP == 101
    xcd_barrier(bar); if (PH(0)) { LANE_IDS; phase_prologue(A, lds, tid, lane, wave, G); }
#endif
    SEAM(0);
#if MK_PROBE_REP == 103
    if (PH(1)) { LANE_IDS; const f32x4* src_ = (const f32x4*)A.in[I_XP]; f32x4* dst_ = (f32x4*)(A.ws + WS_HID);
        for (int m = blockIdx.x * 8 + wave; m < 32768; m += G * 8) { f32x4 v_[8];
#pragma unroll
            for (int j = 0; j < 8; ++j) v_[j] = __builtin_nontemporal_load(src_ + (size_t)m * 512 + lane + 64 * j);
#pragma unroll
            for (int j = 0; j < 8; ++j) __builtin_nontemporal_store(v_[j], dst_ + (size_t)m * 512 + lane + 64 * j); } }
    if (PH(1)) xcd_barrier(bar);
#endif
    if (PH(1)) { LANE_IDS; phase_resnorm(A, lds, 0, 0, tid, lane, wave, G); }
#if MK_PROBE_REP == 102
    xcd_barrier(bar); if (PH(1)) { LANE_IDS; phase_resnorm(A, lds, 0, 0, tid, lane, wave, G); }
#endif
    SEAM(1);
#pragma unroll 1
    for (int l = 0; l < DEPTH; ++l) {
        const int b = 2 + 10 * l;
        if (PH(b + 0)) { LANE_IDS;
            pg8::Gemm g{(const pg8::bf16_t*)(A.ws + WS_HB), (const pg8::bf16_t*)(A.ws + WS_WIN) + (size_t)(l & 1) * NIN * D, TOK, l == 0 ? NIN - 256 : NIN, D}; pg8::StaticOrder S; S.init(TOK, l == 0 ? NIN - 256 : NIN, G, (int)blockIdx.x);
            pg8::EpiOut<0> E{(pg8::bf16_t*)(A.ws + WS_QKV), NQKV, (pg8::bf16_t*)(A.ws + WS_LORA), NLB, NQKV / 256, (pg8::bf16_t*)(A.ws + WS_RBUF), 12, TOK};
            pg8::gemm_phase<pg8::EpiOut<0>, pg8::StaticOrder, true, true>(lds + L_RING, g, S, E, tid);
        }
#if MK_PROBE_REP == 0
        xcd_barrier(bar);
        if (PH(b + 0)) { LANE_IDS;
            pg8::Gemm g{(const pg8::bf16_t*)(A.ws + WS_HB), (const pg8::bf16_t*)(A.ws + WS_WIN) + (size_t)(l & 1) * NIN * D, TOK, l == 0 ? NIN - 256 : NIN, D}; pg8::StaticOrder S; S.init(TOK, l == 0 ? NIN - 256 : NIN, G, (int)blockIdx.x);
            pg8::EpiOut<0> E{(pg8::bf16_t*)(A.ws + WS_QKV), NQKV, (pg8::bf16_t*)(A.ws + WS_LORA), NLB, NQKV / 256, (pg8::bf16_t*)(A.ws + WS_RBUF), 12, TOK};
            pg8::gemm_phase<pg8::EpiOut<0>, pg8::StaticOrder, true, true>(lds + L_RING, g, S, E, tid);
        }
#endif
        SEAM(b + 0);
        if (PH(b + 1)) { LANE_IDS; phase_attention(A, lds, l, tid, lane, wave, G); }
#if MK_PROBE_REP == 1
        xcd_barrier(bar); if (PH(b + 1)) { LANE_IDS; phase_attention(A, lds, l, tid, lane, wave, G); }
#endif
        SEAM(b + 1);
        if (PH(b + 2)) { LANE_IDS; phase_prep(A, lds, l, tid, lane, wave, G); }
#if MK_PROBE_REP == 2
        xcd_barrier(bar); if (PH(b + 2)) { LANE_IDS; phase_prep(A, lds, l, tid, lane, wave, G); }
#endif
        SEAM(b + 2);
        if (PH(b + 3)) { LANE_IDS; phase_scan(A, lds, l, lane, wave, G); }
#if MK_PROBE_REP == 3
        xcd_barrier(bar); if (PH(b + 3)) { LANE_IDS; phase_scan(A, lds, l, lane, wave, G); }
#endif
        SEAM(b + 3);
        if (PH(b + 4)) { LANE_IDS; phase_post(A, l, lane, wave, G); }
        SEAM(b + 4);
        if (PH(b + 5)) { LANE_IDS;
            pg8::Gemm g{(const pg8::bf16_t*)(A.ws + WS_MIXIN), (const pg8::bf16_t*)(A.ws + WS_WOUT) + (size_t)(l & 1) * D * D, TOK, D, D}; pg8::StaticOrder S; S.init(TOK, D, G, (int)blockIdx.x);
            pg8::EpiOut<0> E{(pg8::bf16_t*)(A.ws + WS_RBUF), D, nullptr, 0, 1 << 30, nullptr, 0, 0};
            pg8::gemm_phase<pg8::EpiOut<0>, pg8::StaticOrder, true, true>(lds + L_RING, g, S, E, tid);
        }
#if MK_PROBE_REP == 5
        xcd_barrier(bar);
        if (PH(b + 5)) { LANE_IDS;
            pg8::Gemm g{(const pg8::bf16_t*)(A.ws + WS_MIXIN), (const pg8::bf16_t*)(A.ws + WS_WOUT) + (size_t)(l & 1) * D * D, TOK, D, D}; pg8::StaticOrder S; S.init(TOK, D, G, (int)blockIdx.x);
            pg8::EpiOut<0> E{(pg8::bf16_t*)(A.ws + WS_RBUF), D, nullptr, 0, 1 << 30, nullptr, 0, 0};
            pg8::gemm_phase<pg8::EpiOut<0>, pg8::StaticOrder, true, true>(lds + L_RING, g, S, E, tid);
        }
#endif
        SEAM(b + 5);
        if (PH(b + 6)) { LANE_IDS; phase_resnorm(A, lds, l, 1, tid, lane, wave, G); }
        SEAM(b + 6);
        if (PH(b + 7)) { LANE_IDS;
            pg8::Gemm g{(const pg8::bf16_t*)(A.ws + WS_HB), (const pg8::bf16_t*)(A.ws + WS_WF1), TOK, DFF, D}; pg8::StaticOrder S; S.init(TOK, DFF, G, (int)blockIdx.x);
            pg8::EpiOut<1> E{(pg8::bf16_t*)(A.ws + WS_HID), DFF, nullptr, 0, 1 << 30, nullptr, 0, 0};
            pg8::gemm_phase<pg8::EpiOut<1>, pg8::StaticOrder, true, true>(lds + L_RING, g, S, E, tid);
        }
#if MK_PROBE_REP == 7
        xcd_barrier(bar);
        if (PH(b + 7)) { LANE_IDS;
            pg8::Gemm g{(const pg8::bf16_t*)(A.ws + WS_HB), (const pg8::bf16_t*)(A.ws + WS_WF1), TOK, DFF, D}; pg8::StaticOrder S; S.init(TOK, DFF, G, (int)blockIdx.x);
            pg8::EpiOut<1> E{(pg8::bf16_t*)(A.ws + WS_HID), DFF, nullptr, 0, 1 << 30, nullptr, 0, 0};
            pg8::gemm_phase<pg8::EpiOut<1>, pg8::StaticOrder, true, true>(lds + L_RING, g, S, E, tid);
        }
#endif
        SEAM(b + 7);
        if (PH(b + 8)) { LANE_IDS;
            pg8::Gemm g{(const pg8::bf16_t*)(A.ws + WS_HID), (const pg8::bf16_t*)(A.ws + WS_WF2), TOK, D, DFF}; pg8::StaticOrder S; S.init(TOK, D, G, (int)blockIdx.x);
            pg8::EpiOut<0> E{(pg8::bf16_t*)(A.ws + WS_EX), D, nullptr, 0, 1 << 30, nullptr, 0, 0};
            pg8::gemm_phase<pg8::EpiOut<0>, pg8::StaticOrder, true, true>(lds + L_RING, g, S, E, tid);
        }
#if MK_PROBE_REP == 8
        xcd_barrier(bar);
        if (PH(b + 8)) { LANE_IDS;
            pg8::Gemm g{(const pg8::bf16_t*)(A.ws + WS_HID), (const pg8::bf16_t*)(A.ws + WS_WF2), TOK, D, DFF}; pg8::StaticOrder S; S.init(TOK, D, G, (int)blockIdx.x);
            pg8::EpiOut<0> E{(pg8::bf16_t*)(A.ws + WS_EX), D, nullptr, 0, 1 << 30, nullptr, 0, 0};
            pg8::gemm_phase<pg8::EpiOut<0>, pg8::StaticOrder, true, true>(lds + L_RING, g, S, E, tid);
        }
#endif
        SEAM(b + 8);
        if (PH(b + 9)) { LANE_IDS; phase_resnorm(A, lds, l, 2, tid, lane, wave, G); }
        SEAM(b + 9);
    }
#undef PH
#undef SEAM
}

extern "C" void kernel_launch(void* const* d_in, const int* in_sizes, int n_in, void* d_out, int out_size, void* d_ws, size_t ws_size, hipStream_t stream) {
    static int grid = 0;
    if (grid == 0) {
        if (n_in != 35 || out_size != TOK * D || ws_size < WS_END) { fprintf(stderr, "kernel_launch: unexpected problem (n_in %d, out %d, ws %zu); nothing launched\n", n_in, out_size, ws_size); grid = -1; return; }
        int dev = 0, cus = 0, per_cu = 0;
        if (hipGetDevice(&dev) != hipSuccess || hipDeviceGetAttribute(&cus, hipDeviceAttributeMultiprocessorCount, dev) != hipSuccess) { grid = -1; return; }
        if (hipFuncSetAttribute((const void*)hymba_fwd, hipFuncAttributeMaxDynamicSharedMemorySize, LDS_BYTES) != hipSuccess) { fprintf(stderr, "kernel_launch: hipFuncSetAttribute failed\n"); grid = -1; return; }
        if (hipOccupancyMaxActiveBlocksPerMultiprocessor(&per_cu, (const void*)hymba_fwd, 512, LDS_BYTES) != hipSuccess || per_cu < 1) { fprintf(stderr, "kernel_launch: occupancy query says %d blocks per CU\n", per_cu); (void)hipGetLastError(); grid = -1; return; }
        grid = cus;
    }
    if (grid < 0) return;
    (void)hipMemsetAsync((char*)d_ws + WS_CTL, 0, CTL_ZERO_BYTES, stream);
    Args a{};
    for (int i = 0; i < 35; ++i) a.in[i] = (const float*)d_in[i];
    a.out = (float*)d_out; a.ws = (unsigned char*)d_ws;
#if MK_LAUNCH_PER_PHASE
    for (int p = 0; p < NPHASE; ++p) { a.ph_lo = p; a.ph_hi = p + 1; hipLaunchKernelGGL(hymba_fwd, dim3(grid), dim3(512), LDS_BYTES, stream, a); }
#else
    a.ph_lo = 0; a.ph_hi = NPHASE; hipLaunchKernelGGL(hymba_fwd, dim3(grid), dim3(512), LDS_BYTES, stream, a);
#endif
    const hipError_t le = hipPeekAtLastError();
    if (le != hipSuccess) fprintf(stderr, "kernel_launch: launch failed: %s\n", hipGetErrorName(le));
}
```

```cpp
#include <hip/hip_runtime.h>
#include <cstdio>
#include <cstdint>

#ifndef MK_LAUNCH_PER_PHASE
#define MK_LAUNCH_PER_PHASE 0
#define MK_PROBE_REP -1
#define MK_PREP_PROBE 0
#endif
namespace pg8 {
#define PG8_LAS __attribute__((address_space(3)))
typedef unsigned short bf16_t;
typedef short bf16x8 __attribute__((ext_vector_type(8)));
typedef float f32x4 __attribute__((ext_vector_type(4)));
typedef unsigned u32x4 __attribute__((ext_vector_type(4)));
constexpr int BM = 256, BK = 64, HALF = 128, HTB = HALF * BK * 2  , STAGE_BYTES = 8 * HTB, NXCD = 8, WGM = 4;

__host__ __device__ __forceinline__ int lds_byte(int r, int c) { const int st = (r >> 4) * 2 + (c >> 5), rr = r & 15, cc = c & 31, ob = rr * 64 + cc * 2; return st * 1024 + (ob ^ (((ob >> 9) & 1) << 5)); }
__host__ __device__ __forceinline__ void stage_rc(int b, int& R, int& C) { const int st = b / 1024, sb = b % 1024, swz = sb ^ (((sb >> 9) & 1) << 5); R = (st >> 1) * 16 + swz / 64; C = (st & 1) * 32 + (swz % 64) / 2; }
__host__ __device__ __forceinline__ int perm32(int rho) { const int n = rho >> 4, i = rho & 15; return 8 * (i >> 2) + 4 * n + (i & 3); }

struct Unit { int pm, pn; };
struct Gemm { const bf16_t* A; const bf16_t* Bt; int M, N, K; };

struct StaticOrder {
    int nM, nN, nwg, G, c;
    __host__ __device__ void init(int M, int N, int G_, int c_) { nM = M / BM; nN = N / BM; nwg = nM * nN; G = G_; c = c_; }
    __host__ __device__ bool next(int i, Unit& u) const {
        const long L = (long)i * G + c; if (L >= nwg) return false;
        int wgid = (int)L; { const int q = nwg / NXCD, r = nwg % NXCD, xcd = wgid % NXCD, off = wgid / NXCD; wgid = (xcd < r ? xcd * (q + 1) : r * (q + 1) + (xcd - r) * q) + off; }
        const int nig = WGM * nN, gid = wgid / nig, fm = gid * WGM, gsz = (nM - fm) < WGM ? (nM - fm) : WGM;
        u.pm = fm + ((wgid % nig) % gsz); u.pn = (wgid % nig) / gsz; return true;
    }
    __device__ __forceinline__ void a_ready(const Unit&) const {}
    __device__ __forceinline__ void done(const Unit&) const {}
};
__device__ __forceinline__ unsigned cvt_pk_bf16(float lo, float hi) { unsigned r; asm volatile("v_cvt_pk_bf16_f32 %0, %1, %2" : "=v"(r) : "v"(lo), "v"(hi)); return r; }
template <int ACT> struct EpiOut {
    static constexpr bool PERM = true, AFTER_DRAIN = false;
    bf16_t* O0; int ld0; bf16_t* O1; int ld1; int split_tile; bf16_t* CG; int cg_tiles; int cg_rows;
    __device__ __forceinline__ void operator()(const f32x4 (&acc)[2][2][4][2], const Unit& u, int wr, int wc, int fr, int fq) const {
        const int row0 = u.pm * BM + wr * 64 + fr;
        bf16_t* base; size_t rstride, bjstep;
        if (u.pn < split_tile) { base = O0 + (size_t)u.pn * BM + wc * 32 + 8 * fq; rstride = (size_t)ld0; bjstep = HALF; }
        else if (u.pn < split_tile + cg_tiles) { base = CG + (size_t)((u.pn - split_tile) * 8 + wc) * cg_rows * 32 + 8 * fq; rstride = 32; bjstep = (size_t)4 * cg_rows * 32; }
        else { base = O1 + (size_t)(u.pn - split_tile - cg_tiles) * BM + wc * 32 + 8 * fq; rstride = (size_t)ld1; bjstep = HALF; }
#pragma unroll
        for (int ai = 0; ai < 2; ++ai)
#pragma unroll
            for (int m = 0; m < 4; ++m) { bf16_t* rowp = base + (size_t)(row0 + ai * HALF + m * 16) * rstride;
#pragma unroll
                for (int bj = 0; bj < 2; ++bj) { f32x4 v0 = acc[ai][bj][m][0], v1 = acc[ai][bj][m][1];
                    if (ACT == 1) {
#pragma unroll
                        for (int j = 0; j < 4; ++j) { const float a = v0[j] > 0.f ? v0[j] : 0.f, b = v1[j] > 0.f ? v1[j] : 0.f; v0[j] = a * a; v1[j] = b * b; } }
                    u32x4 w; w.x = cvt_pk_bf16(v0[0], v0[1]); w.y = cvt_pk_bf16(v0[2], v0[3]); w.z = cvt_pk_bf16(v1[0], v1[1]); w.w = cvt_pk_bf16(v1[2], v1[3]);
                    if (ACT == 1) __builtin_nontemporal_store(w, (u32x4*)(rowp + bj * bjstep)); else *(u32x4*)(rowp + bj * bjstep) = w;
#if defined(MK_PREP_PROBE) && MK_PREP_PROBE == 6
                    if (ACT == 1) { asm volatile("" ::: "memory"); *(u32x4*)(rowp + bj * bjstep) = w; }
#endif
                    } }
    }
};

template <class Epi, class Sched, bool ALIGN_EPI = false, bool SP2 = false>
__device__ __forceinline__ void gemm_phase(PG8_LAS unsigned char* lds, const Gemm g, const Sched& S, const Epi& E, const int tid) {
    const int wid = __builtin_amdgcn_readfirstlane(tid >> 6), lane = tid & 63, wr = wid >> 2, wc = wid & 3, fr = lane & 15, fq = lane >> 4;
    const int K = g.K, nt = K / BK;
    unsigned voffA[2], voffB[2];
#pragma unroll
    for (int i = 0; i < 2; ++i) { int R, C; stage_rc(tid * 16 + i * 8192, R, C); const int Rb = Epi::PERM ? ((R & ~31) + perm32(R & 31)) : R;
        voffA[i] = (unsigned)(R * K + C) * 2u; voffB[i] = (unsigned)(Rb * K + C) * 2u; }
    const size_t kstep = (size_t)(BK * 2);
    const size_t hstep = (size_t)HALF * K * 2;
    const size_t tstep = 2 * hstep;
    const unsigned ldsw = (unsigned)wid * 1024u;
    const int aoff = lds_byte(wr * 64 + fr, fq * 8), boff = lds_byte(wc * 32 + fr, fq * 8);
#define PG8_SA(b, h) (((b) * 2 + (h)) * HTB)
#define PG8_SB(b, h) ((4 + (b) * 2 + (h)) * HTB)
#define PG8_STAGE(bufoff, gbase, voff) do { _Pragma("unroll") for (int _i = 0; _i < 2; ++_i) \
        __builtin_amdgcn_global_load_lds((const unsigned*)((const char*)(gbase) + (voff)[_i]), (PG8_LAS unsigned*)(lds + (bufoff) + ldsw + _i * 8192), 16, 0, 0); } while (0)
#define PG8_LDA(dst, b, h) do { _Pragma("unroll") for (int m = 0; m < 4; ++m) _Pragma("unroll") for (int k = 0; k < 2; ++k) dst[m][k] = *(const PG8_LAS bf16x8*)(lds + PG8_SA(b, h) + aoff + m * 2048 + k * 1024); } while (0)
#define PG8_LDB(dst, b, h) do { _Pragma("unroll") for (int n = 0; n < 2; ++n) _Pragma("unroll") for (int k = 0; k < 2; ++k) dst[n][k] = *(const PG8_LAS bf16x8*)(lds + PG8_SB(b, h) + boff + n * 2048 + k * 1024); } while (0)
#define PG8_MMA(ai, bj, At, Bt) do { __builtin_amdgcn_s_setprio(1); _Pragma("unroll") for (int m = 0; m < 4; ++m) _Pragma("unroll") for (int n = 0; n < 2; ++n) _Pragma("unroll") for (int k = 0; k < 2; ++k) \
        acc[ai][bj][m][n] = __builtin_amdgcn_mfma_f32_16x16x32_bf16(Bt[n][k], At[m][k], acc[ai][bj][m][n], 0, 0, 0); __builtin_amdgcn_s_setprio(0); } while (0)
#define PG8_WAIT_V(n) asm volatile("s_waitcnt vmcnt(" #n ")" ::: "memory")
#define PG8_WAIT_L(n) asm volatile("s_waitcnt lgkmcnt(" #n ")" ::: "memory")
#define PG8_BAR __builtin_amdgcn_s_barrier()
#define PG8_SCHED __builtin_amdgcn_sched_barrier(0)
    Unit cur, nxt; int ui = 0;
    if (!S.next(0, cur)) return;
    f32x4 acc[2][2][4][2];
#pragma unroll
    for (int a = 0; a < 2; ++a)
#pragma unroll
        for (int b = 0; b < 2; ++b)
#pragma unroll
            for (int m = 0; m < 4; ++m)
#pragma unroll
                for (int n = 0; n < 2; ++n) acc[a][b][m][n] = (f32x4){0.f, 0.f, 0.f, 0.f};
    bf16x8 At[4][2], B0[2][2], B1[2][2];
    const char* cA = (const char*)g.A + (size_t)cur.pm * tstep; const char* cB = (const char*)g.Bt + (size_t)cur.pn * tstep;
    S.a_ready(cur);
    if constexpr (SP2) {
        PG8_STAGE(PG8_SB(0, 0), cB, voffB); PG8_STAGE(PG8_SB(0, 1), cB + hstep, voffB); PG8_STAGE(PG8_SA(0, 0), cA, voffA); PG8_STAGE(PG8_SA(0, 1), cA + hstep, voffA);
        if (wr == 1) PG8_BAR;
        PG8_WAIT_V(2); PG8_BAR;
        PG8_STAGE(PG8_SB(1, 0), cB + kstep, voffB); PG8_STAGE(PG8_SA(1, 0), cA + kstep, voffA); PG8_STAGE(PG8_SB(1, 1), cB + hstep + kstep, voffB);
        PG8_WAIT_V(6); PG8_BAR;
    } else {
        PG8_STAGE(PG8_SB(0, 0), cB, voffB); PG8_STAGE(PG8_SA(0, 0), cA, voffA); PG8_STAGE(PG8_SB(0, 1), cB + hstep, voffB); PG8_STAGE(PG8_SA(0, 1), cA + hstep, voffA);
        if (wr == 1) PG8_BAR;
        PG8_WAIT_V(4); PG8_BAR;
        PG8_STAGE(PG8_SB(1, 0), cB + kstep, voffB); PG8_STAGE(PG8_SA(1, 0), cA + kstep, voffA); PG8_STAGE(PG8_SB(1, 1), cB + hstep + kstep, voffB);
        PG8_WAIT_V(6); PG8_BAR;
    }
    for (;;) {
        const bool has_next = S.next(ui + 1, nxt);
        const char* nA = has_next ? (const char*)g.A + (size_t)nxt.pm * tstep : cA; const char* nB = has_next ? (const char*)g.Bt + (size_t)nxt.pn * tstep : cB;
        for (int t = 0; t < nt; t += 2) {
            const bool last = (t == nt - 2);
            const char* a1 = cA + (size_t)(t + 1) * kstep;
            const char* a2 = last ? nA : cA + (size_t)(t + 2) * kstep; const char* b2 = last ? nB : cB + (size_t)(t + 2) * kstep;
            const char* a3 = a2 + kstep; const char* b3 = b2 + kstep;
            if (last && has_next) S.a_ready(nxt);
            if constexpr (SP2) {
            PG8_LDB(B0, 0, 0); PG8_LDB(B1, 0, 1); PG8_SCHED; PG8_LDA(At, 0, 0); PG8_STAGE(PG8_SA(1, 1), a1 + hstep, voffA);
            PG8_WAIT_V(8); PG8_WAIT_L(0); PG8_BAR; PG8_MMA(0, 0, At, B0); PG8_MMA(0, 1, At, B1); PG8_BAR; PG8_SCHED;
            PG8_LDA(At, 0, 1); PG8_STAGE(PG8_SB(0, 0), b2, voffB); PG8_STAGE(PG8_SB(0, 1), b2 + hstep, voffB); PG8_STAGE(PG8_SA(0, 0), a2, voffA);
            PG8_WAIT_V(8); PG8_WAIT_L(0); PG8_BAR; PG8_MMA(1, 0, At, B0); PG8_MMA(1, 1, At, B1); PG8_BAR; PG8_SCHED;
            PG8_LDB(B0, 1, 0); PG8_LDB(B1, 1, 1); PG8_SCHED; PG8_LDA(At, 1, 0); PG8_STAGE(PG8_SA(0, 1), a2 + hstep, voffA);
            PG8_WAIT_V(8); PG8_WAIT_L(0); PG8_BAR; PG8_MMA(0, 0, At, B0); PG8_MMA(0, 1, At, B1); PG8_BAR; PG8_SCHED;
            PG8_LDA(At, 1, 1); PG8_STAGE(PG8_SB(1, 0), b3, voffB); PG8_STAGE(PG8_SB(1, 1), b3 + hstep, voffB); PG8_STAGE(PG8_SA(1, 0), a3, voffA);
            PG8_WAIT_V(8); PG8_WAIT_L(0); PG8_BAR; PG8_MMA(1, 0, At, B0); PG8_MMA(1, 1, At, B1); PG8_BAR; PG8_SCHED;
            } else {
            PG8_LDB(B0, 0, 0); PG8_SCHED; PG8_LDA(At, 0, 0); PG8_STAGE(PG8_SA(1, 1), a1 + hstep, voffA);
            PG8_WAIT_L(8); PG8_BAR; PG8_WAIT_L(0); PG8_MMA(0, 0, At, B0); PG8_BAR; PG8_SCHED;
            PG8_LDB(B1, 0, 1); PG8_STAGE(PG8_SB(0, 0), b2, voffB);
            PG8_BAR; PG8_WAIT_L(0); PG8_MMA(0, 1, At, B1); PG8_BAR;
            PG8_LDA(At, 0, 1); PG8_STAGE(PG8_SA(0, 0), a2, voffA);
            PG8_BAR; PG8_WAIT_L(0); PG8_MMA(1, 0, At, B0); PG8_BAR; PG8_SCHED;
            PG8_STAGE(PG8_SB(0, 1), b2 + hstep, voffB);
            PG8_WAIT_V(6); PG8_BAR; PG8_MMA(1, 1, At, B1); PG8_BAR;
            PG8_LDB(B0, 1, 0); PG8_SCHED; PG8_LDA(At, 1, 0); PG8_STAGE(PG8_SA(0, 1), a2 + hstep, voffA);
            PG8_WAIT_L(8); PG8_BAR; PG8_WAIT_L(0); PG8_MMA(0, 0, At, B0); PG8_BAR; PG8_SCHED;
            PG8_LDB(B1, 1, 1); PG8_STAGE(PG8_SB(1, 0), b3, voffB);
            PG8_BAR; PG8_WAIT_L(0); PG8_MMA(0, 1, At, B1); PG8_BAR;
            PG8_LDA(At, 1, 1); PG8_STAGE(PG8_SA(1, 0), a3, voffA);
            PG8_BAR; PG8_WAIT_L(0); PG8_MMA(1, 0, At, B0); PG8_BAR; PG8_SCHED;
            PG8_STAGE(PG8_SB(1, 1), b3 + hstep, voffB);
            PG8_WAIT_V(6); PG8_BAR; PG8_MMA(1, 1, At, B1); PG8_BAR;
            }
        }
        if constexpr (ALIGN_EPI) { if (wr == 0) PG8_BAR; }
        if constexpr (!Epi::AFTER_DRAIN) { E(acc, cur, wr, wc, fr, fq); S.done(cur); }
        if (!has_next) break;
#pragma unroll
        for (int a = 0; a < 2; ++a)
#pragma unroll
            for (int b = 0; b < 2; ++b)
#pragma unroll
                for (int m = 0; m < 4; ++m)
#pragma unroll
                    for (int n = 0; n < 2; ++n) acc[a][b][m][n] = (f32x4){0.f, 0.f, 0.f, 0.f};
        cur = nxt; cA = nA; cB = nB; ++ui;
        if constexpr (ALIGN_EPI) { if (wr == 1) PG8_BAR; }
    }
    PG8_WAIT_V(0);
    if constexpr (!ALIGN_EPI) { if (wr == 0) PG8_BAR; }
    PG8_BAR;
    if constexpr (Epi::AFTER_DRAIN) { E.fused(acc, cur, wr, wc, fr, fq, lds, wid, lane); S.done(cur); }
#undef PG8_SA
#undef PG8_SB
#undef PG8_STAGE
#undef PG8_LDA
#undef PG8_LDB
#undef PG8_MMA
#undef PG8_WAIT_V
#undef PG8_WAIT_L
#undef PG8_BAR
#undef PG8_SCHED
}
}
#define XB_TMO      128
#define XB_XCNT(j)  (256  + 64 * (j))
#define XB_XSUB(j)  (1280 + 64 * (j))
#define XB_XGEN(j)  (2304 + 64 * (j))
#define XB_TOP      3328
#define XB_TOPGEN   3392
#define XCD_BAR_WORDS 3456
#define XB_SPIN_CAP (1u << 18)
#define LAS __attribute__((address_space(3)))

__device__ __forceinline__ unsigned xb_ld(unsigned* p)              { return __hip_atomic_load(p, __ATOMIC_RELAXED, __HIP_MEMORY_SCOPE_AGENT); }
__device__ __forceinline__ unsigned xb_add(unsigned* p, unsigned v) { return __hip_atomic_fetch_add(p, v, __ATOMIC_RELAXED, __HIP_MEMORY_SCOPE_AGENT); }
__device__ __forceinline__ unsigned xb_xcc_id() { return (unsigned)__builtin_amdgcn_s_getreg((3 << 11) | 20) & 0xFu; }
#define XB_SPIN(cond, bar) do { unsigned _sp = 0; while (cond) { __builtin_amdgcn_s_sleep(1); \
    if ((++_sp & 255u) == 0u) { if (xb_ld(&(bar)[XB_TMO])) break; if (_sp > XB_SPIN_CAP) { atomicAdd(&(bar)[XB_TMO], 1u); break; } } } } while (0)

struct XcdBarrier {
    unsigned* bar; unsigned x;
    volatile LAS unsigned* st;
};

__device__ __forceinline__ XcdBarrier xcd_barrier_post(unsigned* bar, volatile LAS unsigned* st) {
    XcdBarrier b; b.bar = bar; b.x = xb_xcc_id(); b.st = st;
    if (threadIdx.x == 0) (void)xb_add(&bar[XB_XCNT(b.x)], 1u);
    return b;
}
__device__ __forceinline__ void xcd_barrier_complete(unsigned* bar, unsigned x, unsigned& nloc, unsigned& nx) {
    const unsigned G = gridDim.x * gridDim.y * gridDim.z;
    unsigned sum, cnt, mine, sp = 0u;
    for (;;) {
        sum = 0u; cnt = 0u; mine = 0u;
#pragma unroll
        for (unsigned j = 0; j < 16; ++j) { const unsigned c = xb_ld(&bar[XB_XCNT(j)]); sum += c; cnt += (c > 0u) ? 1u : 0u; mine = (j == x) ? c : mine; }
        if (sum == G) break;
        __builtin_amdgcn_s_sleep(1);
        if ((++sp & 255u) == 0u) { if (xb_ld(&bar[XB_TMO])) break; if (sp > XB_SPIN_CAP) { atomicAdd(&bar[XB_TMO], 1u); break; } }
    }
    nloc = mine > 0u ? mine : 1u; nx = cnt > 0u ? cnt : 1u;
}

__device__ __forceinline__ void xcd_barrier(const XcdBarrier& b) {
    asm volatile("s_waitcnt vmcnt(0)" ::: "memory");
    __syncthreads();
    if (threadIdx.x == 0) {
        unsigned* bar = b.bar;
        __builtin_amdgcn_s_waitcnt(0);
        unsigned nloc = b.st[0], nx = b.st[1];
        if (nloc == 0u) { xcd_barrier_complete(bar, b.x, nloc, nx); b.st[0] = nloc; b.st[1] = nx; }
        const unsigned old = xb_add(&bar[XB_XSUB(b.x)], 1u);
        const unsigned gen = old / nloc;
        if (old + 1u == (gen + 1u) * nloc) {
            __builtin_amdgcn_fence(__ATOMIC_RELEASE, "agent");
            asm volatile("s_waitcnt vmcnt(0)" ::: "memory");
            const unsigned og = xb_add(&bar[XB_TOP], 1u);
            const unsigned tg = og / nx;
            if (og + 1u == (tg + 1u) * nx) xb_add(&bar[XB_TOPGEN], 1u);
            else XB_SPIN(xb_ld(&bar[XB_TOPGEN]) == tg, bar);
            __builtin_amdgcn_fence(__ATOMIC_ACQUIRE, "agent");
            xb_add(&bar[XB_XGEN(b.x)], 1u);
            asm volatile("s_waitcnt vmcnt(0)" ::: "memory");
        } else {
            XB_SPIN(xb_ld(&bar[XB_XGEN(b.x)]) == gen, bar);
            __builtin_amdgcn_fence(__ATOMIC_ACQUIRE, "agent");
            asm volatile("s_waitcnt vmcnt(0)" ::: "memory");
        }
    }
    __syncthreads();
}
constexpr int D = 2048, DEPTH = 4, NSEQ = 12, TOK = 40960, TP = 32768;
constexpr int NAH = 8, NRH = 16, DFF = 8192;
constexpr int LORA = 352;
constexpr int NPROJ = 6144, NIN = 7424;
constexpr int NQKV = 3072, NLB = 1280;
constexpr int NT64 = TOK / 64;
constexpr float NORM_EPS = 1e-6f, GN_EPS = 64e-5f;

constexpr size_t MiB = 1u << 20;
constexpr size_t WS_CTL = 0, CTL_ZERO_BYTES = 1 * MiB;
constexpr size_t WS_MOD = 1 * MiB;
constexpr size_t WS_LUP = 4 * MiB;
constexpr size_t WS_WIN = 8 * MiB;
constexpr size_t WS_WOUT = 66 * MiB;
constexpr size_t WS_XB = 82 * MiB;
constexpr size_t WS_WF1 = 242 * MiB;
constexpr size_t WS_WF2 = 274 * MiB;
constexpr size_t WS_VFIRST = 306 * MiB;
constexpr size_t WS_HB = 386 * MiB;
constexpr size_t WS_EX = 546 * MiB;
constexpr size_t WS_QKV = 706 * MiB;
constexpr size_t WS_RBUF = 946 * MiB;
constexpr size_t WS_LORA = 1186 * MiB;
constexpr size_t WS_MIXIN = 1286 * MiB;
constexpr size_t WS_KN = 1446 * MiB;
constexpr size_t WS_SSQ = 1454 * MiB;
constexpr size_t WS_G = 1456 * MiB;
constexpr size_t WS_END = 1536 * MiB;
constexpr size_t WS_HID = WS_QKV;
constexpr size_t PLANE = (size_t)TOK * 1024;
constexpr int LUP_W2 = 0, LUP_A2 = 131072, LUP_G2 = 262144, LUP_V2 = 327680, LUP_LAYER = 360448;
constexpr int CW_BAR = 4096;

constexpr int LDS_BYTES = 163840;
constexpr int L_RING = 0;
constexpr int L_BIAS = 131072;
constexpr int L_EXCH = 147456;
constexpr int L_MISC = 163584;
constexpr int L_TRS = 8448;
constexpr int L_PRM = 69632;

#define DI __device__ __forceinline__
typedef unsigned short bf16;
typedef unsigned u32x4 __attribute__((ext_vector_type(4)));
typedef unsigned u32x2 __attribute__((ext_vector_type(2)));
typedef float f32x4 __attribute__((ext_vector_type(4)));
typedef float f32x2 __attribute__((ext_vector_type(2)));
typedef float f32x16 __attribute__((ext_vector_type(16)));
typedef short bf16x8 __attribute__((ext_vector_type(8)));
typedef short s16x4 __attribute__((ext_vector_type(4)));
typedef _Float16 f16x2 __attribute__((ext_vector_type(2)));

DI float bflo(unsigned w) { return __uint_as_float(w << 16); }
DI float bfhi(unsigned w) { return __uint_as_float(w & 0xffff0000u); }
DI unsigned f2bf(float f) { unsigned u = __float_as_uint(f); return (u + 0x7fffu + ((u >> 16) & 1u)) >> 16; }
typedef __bf16 bf16v2_t __attribute__((ext_vector_type(2)));
DI unsigned pkbf(float lo, float hi) { return __builtin_bit_cast(unsigned, __builtin_convertvector((f32x2){lo, hi}, bf16v2_t)); }
DI unsigned pk2(float lo, float hi) { return pkbf(lo, hi); }
DI unsigned pkh2(float lo, float hi) { f16x2 v; v.x = (_Float16)lo; v.y = (_Float16)hi; return __builtin_bit_cast(unsigned, v); }
DI float hlo(unsigned w) { return (float)__builtin_bit_cast(f16x2, w).x; }
DI float hhi(unsigned w) { return (float)__builtin_bit_cast(f16x2, w).y; }
DI float h2f(unsigned short h) { return (float)__builtin_bit_cast(_Float16, h); }
DI unsigned short f2h(float f) { return __builtin_bit_cast(unsigned short, (_Float16)f); }
DI float wave_sum(float v) {
#pragma unroll
    for (int o = 1; o < 64; o <<= 1) v += __shfl_xor(v, o);
    return v;
}
#define DPP_ROR_ADD(v, n) ((v) + __builtin_bit_cast(float, __builtin_amdgcn_update_dpp(0, __builtin_bit_cast(int, (v)), 0x120 + (n), 0xf, 0xf, false)))
DI float wave_sum_dpp(float v) {
    v = DPP_ROR_ADD(v, 8); v = DPP_ROR_ADD(v, 4); v = DPP_ROR_ADD(v, 2); v = DPP_ROR_ADD(v, 1);
    const int b = __builtin_bit_cast(int, v);
    return (__builtin_bit_cast(float, __builtin_amdgcn_readlane(b, 0)) + __builtin_bit_cast(float, __builtin_amdgcn_readlane(b, 16))) +
           (__builtin_bit_cast(float, __builtin_amdgcn_readlane(b, 32)) + __builtin_bit_cast(float, __builtin_amdgcn_readlane(b, 48)));
}
DI float sigmoidf_(float x) { return __builtin_amdgcn_rcpf(1.0f + __expf(-x)); }
DI float tanhf_(float x) { const float e = __expf(2.0f * x); return 1.0f - 2.0f * __builtin_amdgcn_rcpf(1.0f + e); }
DI int seq_start(int s) { return s < 8 ? s * 4096 : TP + (s - 8) * 2048; }
DI int seq_len(int s) { return s < 8 ? 4096 : 2048; }
DI void tokinfo(int m, int& s, int& t, int& T) { if (m < TP) { s = m >> 12; t = m & 4095; T = 4096; } else { const int mm = m - TP; s = 8 + (mm >> 11); t = mm & 2047; T = 2048; } }

struct Args { const float* in[35]; float* out; unsigned char* ws; int ph_lo, ph_hi; };
typedef const __attribute__((address_space(4))) Args CArgs;
enum { I_XP = 0, I_XS, I_CP, I_CS, I_WADA, I_BADA, I_GPREMIX, I_GPOSTMIX, I_GPREFFN, I_GPOSTFFN, I_WIN, I_RPB, I_GATT, I_MURKV, I_MUX, I_W0, I_W1, I_W2, I_A0, I_A1, I_A2,
       I_G1, I_G2, I_MUV, I_V0, I_V1, I_V2, I_KK, I_KA, I_RK, I_LNW, I_LNB, I_WOUT, I_WF1, I_WF2 };
DI const float* mod_ptr(CArgs& a, int l, int s, int k) { return (const float*)(a.ws + WS_MOD) + ((size_t)(l * NSEQ + s) * 6 + k) * D; }
template <int KB>
DI void transpose_item(const float* W, int K, int N, bf16* WT, int row_off, LAS float* scr, int item, int lane, const float* mu, int variant) {
    const int nblk = N / 32, kb = item / nblk, nb = item % nblk, k0 = KB * kb, n0 = 32 * nb;
#pragma unroll 8
    for (int i = 0; i < KB / 2; ++i) { const int kk = 2 * i + (lane >> 5); float v = W ? W[(size_t)(k0 + kk) * N + n0 + (lane & 31)] : 0.f;
        if (mu) { const float m0 = mu[k0 + kk], m1 = mu[K + k0 + kk]; v *= (variant == 0) ? (1.0f - m0 - m1) : (variant == 1 ? m0 : m1); }
        scr[kk * 33 + (lane & 31)] = v; }
    asm volatile("s_waitcnt lgkmcnt(0)" ::: "memory");
    constexpr int CH = KB / 8, RPP = 64 / CH;
    const int c = lane % CH;
#pragma unroll
    for (int j = 0; j < 32 / RPP; ++j) { const int n = lane / CH + RPP * j; const LAS float* s = scr + (8 * c) * 33 + n;
        u32x4 o; o.x = pk2(s[0 * 33], s[1 * 33]); o.y = pk2(s[2 * 33], s[3 * 33]); o.z = pk2(s[4 * 33], s[5 * 33]); o.w = pk2(s[6 * 33], s[7 * 33]);
        *(u32x4*)(WT + (size_t)(row_off + n0 + n) * K + k0 + 8 * c) = o; }
    asm volatile("s_waitcnt lgkmcnt(0)" ::: "memory");
}
template <int KB> DI void ffn_weight_item(CArgs& a, int l, int it, LAS float* scr, int lane) {
    constexpr int S = 64 / KB;
    if (it < 8192 * S) transpose_item<KB>(a.in[I_WF1] + (size_t)l * D * DFF, D, DFF, (bf16*)(a.ws + WS_WF1), 0, scr, it, lane, nullptr, 0);
    else transpose_item<KB>(a.in[I_WF2] + (size_t)l * DFF * D, DFF, D, (bf16*)(a.ws + WS_WF2), 0, scr, it - 8192 * S, lane, nullptr, 0);
}
constexpr int IT_WIN = 6144, IT_LORA = 1056, IT_WOUT = 2048, IT_LAYER = IT_WIN + IT_LORA + IT_WOUT;
template <int KB> DI void layer_weight_item(CArgs& a, int l, int r, LAS float* scr, int lane) {
    constexpr int S = 64 / KB;
    bf16* wint = (bf16*)(a.ws + WS_WIN) + (size_t)(l & 1) * NIN * D;
    if (r < IT_WIN * S) { transpose_item<KB>(a.in[I_WIN] + (size_t)l * D * NPROJ, D, NPROJ, wint, 0, scr, r, lane, nullptr, 0); return; }
    r -= IT_WIN * S;
    if (r < IT_LORA * S) {
        if (r < 960 * S) { const int mat = r / (192 * S), variant = (r % (192 * S)) / (64 * S), item = r % (64 * S);
            const float* W; const float* mu;
            if (mat < 2) { W = a.in[I_W1] + (size_t)(l * 2 + mat) * D * 64; mu = a.in[I_MUX] + (size_t)(l * 3 + 0) * 2 * D; }
            else if (mat < 4) { W = a.in[I_A1] + (size_t)(l * 2 + (mat - 2)) * D * 64; mu = a.in[I_MUX] + (size_t)(l * 3 + 1) * 2 * D; }
            else { W = a.in[I_G1] + (size_t)l * D * 64; mu = a.in[I_MUX] + (size_t)(l * 3 + 2) * 2 * D; }
            transpose_item<KB>(W, D, 64, wint, NPROJ + variant * LORA + 64 * mat, scr, item, lane, mu, variant);
        } else { const int jj = r - 960 * S, variant = jj / (32 * S), item = jj % (32 * S);
            const float* W = l > 0 ? a.in[I_V1] + (size_t)(l - 1) * D * 32 : nullptr; const float* mu = l > 0 ? a.in[I_MUV] + (size_t)(l - 1) * 2 * D : nullptr;
            transpose_item<KB>(W, D, 32, wint, NPROJ + variant * LORA + 320, scr, item, lane, mu, variant); }
        return; }
    r -= IT_LORA * S;
    transpose_item<KB>(a.in[I_WOUT] + (size_t)l * D * D, D, D, (bf16*)(a.ws + WS_WOUT) + (size_t)(l & 1) * D * D, 0, scr, r, lane, nullptr, 0);
}
constexpr int BG_FFN = 16384 * 2, BG_LAYER = IT_LAYER * 2;
DI void bg_decode(CArgs& a, int l, int it, const float*& W, const float*& mu, bf16*& WT, int& K, int& N, int& row_off, int& item, int& variant) {
    mu = nullptr; variant = 0; row_off = 0;
    if (it < BG_FFN) {
        if (it < 16384) { W = a.in[I_WF1] + (size_t)l * D * DFF; K = D; N = DFF; WT = (bf16*)(a.ws + WS_WF1); item = it; }
        else { W = a.in[I_WF2] + (size_t)l * DFF * D; K = DFF; N = D; WT = (bf16*)(a.ws + WS_WF2); item = it - 16384; }
        return; }
    const int ln = l + 1; int r = it - BG_FFN;
    bf16* wint = (bf16*)(a.ws + WS_WIN) + (size_t)(ln & 1) * NIN * D;
    if (r < 2 * IT_WIN) { W = a.in[I_WIN] + (size_t)ln * D * NPROJ; K = D; N = NPROJ; WT = wint; item = r; return; }
    r -= 2 * IT_WIN;
    if (r < 2 * IT_LORA) { K = D; WT = wint;
        if (r < 1920) { const int mat = r / 384; variant = (r % 384) / 128; item = r % 128; N = 64;
            if (mat < 2) { W = a.in[I_W1] + (size_t)(ln * 2 + mat) * D * 64; mu = a.in[I_MUX] + (size_t)(ln * 3 + 0) * 2 * D; }
            else if (mat < 4) { W = a.in[I_A1] + (size_t)(ln * 2 + (mat - 2)) * D * 64; mu = a.in[I_MUX] + (size_t)(ln * 3 + 1) * 2 * D; }
            else { W = a.in[I_G1] + (size_t)ln * D * 64; mu = a.in[I_MUX] + (size_t)(ln * 3 + 2) * 2 * D; }
            row_off = NPROJ + variant * LORA + 64 * mat; }
        else { const int jj = r - 1920; variant = jj / 64; item = jj % 64; N = 32;
            W = ln > 0 ? a.in[I_V1] + (size_t)(ln - 1) * D * 32 : nullptr; mu = ln > 0 ? a.in[I_MUV] + (size_t)(ln - 1) * 2 * D : nullptr; row_off = NPROJ + variant * LORA + 320; }
        return; }
    r -= 2 * IT_LORA;
    W = a.in[I_WOUT] + (size_t)ln * D * D; K = D; N = D; WT = (bf16*)(a.ws + WS_WOUT) + (size_t)(ln & 1) * D * D; item = r;
    mu = a.in[I_GATT] + (size_t)ln * 1024; variant = 3;
}
DI void bg_issue(CArgs& a, int l, int it, int lane, f32x4 (&nx)[4]) {
    const float* W; const float* mu; bf16* WT; int K, N, row_off, item, variant;
    bg_decode(a, l, it, W, mu, WT, K, N, row_off, item, variant);
    const int nblk = N >> 5, k0 = 32 * (item / nblk), n0 = 32 * (item % nblk);
    if (!W) {
#pragma unroll
        for (int i = 0; i < 4; ++i) nx[i] = (f32x4){0.f, 0.f, 0.f, 0.f};
        return; }
    const float* p = W + (size_t)(k0 + (lane >> 3)) * N + n0 + 4 * (lane & 7);
#pragma unroll
    for (int i = 0; i < 4; ++i) nx[i] = *(const f32x4*)(p + (size_t)(8 * i) * N);
}
DI void background_weights(CArgs& a, int l, LAS float* scr, int slot, int nslots, int lane) {
    const int total = BG_FFN + (l < 3 ? BG_LAYER : 0);
    f32x4 nx[4];
    int it = (l < 0 ? BG_FFN : 0) + slot;
    if (it < total) bg_issue(a, l, it, lane, nx);
#pragma unroll 1
    for (; it < total; it += nslots) {
        f32x4 v[4];
#pragma unroll
        for (int i = 0; i < 4; ++i) v[i] = nx[i];
        if (it + nslots < total) bg_issue(a, l, it + nslots, lane, nx);
        const float* W; const float* mu; bf16* WT; int K, N, row_off, item, variant;
        bg_decode(a, l, it, W, mu, WT, K, N, row_off, item, variant);
        const int nblk = N >> 5, k0 = 32 * (item / nblk), n0 = 32 * (item % nblk), rr = lane >> 3, cc = 4 * (lane & 7);
#pragma unroll
        for (int i = 0; i < 4; ++i) { const int kk = 8 * i + rr; float sc = 1.0f;
            if (mu) { if (variant == 3) { if (k0 < 1024) sc = mu[k0 + kk]; }
                      else { const float m0 = mu[k0 + kk], m1 = mu[K + k0 + kk]; sc = (variant == 0) ? (1.0f - m0 - m1) : (variant == 1 ? m0 : m1); } }
            LAS float* sp = scr + kk * 33 + cc; sp[0] = v[i].x * sc; sp[1] = v[i].y * sc; sp[2] = v[i].z * sc; sp[3] = v[i].w * sc; }
        asm volatile("s_waitcnt lgkmcnt(0)" ::: "memory");
        const int c = lane & 3;
#pragma unroll
        for (int j = 0; j < 2; ++j) { const int n = (lane >> 2) + 16 * j; const LAS float* sq = scr + (8 * c) * 33 + n;
            u32x4 o; o.x = pk2(sq[0 * 33], sq[1 * 33]); o.y = pk2(sq[2 * 33], sq[3 * 33]); o.z = pk2(sq[4 * 33], sq[5 * 33]); o.w = pk2(sq[6 * 33], sq[7 * 33]);
            *(u32x4*)(WT + (size_t)(row_off + n0 + n) * K + k0 + 8 * c) = o; }
        asm volatile("s_waitcnt lgkmcnt(0)" ::: "memory");
    }
}

DI void phase_prologue(CArgs& a, LAS unsigned char* lds, int tid, int lane, int wave, int G) {
    {   LAS float* sc = (LAS float*)(lds);
        LAS float* part = (LAS float*)(lds + 98304);
        bool have = false;
        for (int it = blockIdx.x; it < 4 * 96; it += G) {
            if (!have) {
#pragma unroll 1
                for (int i0 = tid; i0 < NSEQ * D; i0 += 512 * 8) { float cv[8];
#pragma unroll
                    for (int u = 0; u < 8; ++u) { const int i = i0 + 512 * u, s = i / D, k = i % D; cv[u] = s < 8 ? a.in[I_CP][s * D + k] : a.in[I_CS][(s - 8) * D + k]; }
#pragma unroll
                    for (int u = 0; u < 8; ++u) { const int i = i0 + 512 * u, s = i / D, k = i % D; const float c = cv[u]; sc[k * 12 + s] = c / (1.0f + __expf(-c)); } }
                __syncthreads(); have = true; }
            const int l = it / 96, n0 = (it % 96) * 128;
            const float* W = a.in[I_WADA] + (size_t)l * D * 12288 + n0 + 2 * lane;
            f32x2 acc[12];
#pragma unroll
            for (int s = 0; s < 12; ++s) acc[s] = (f32x2){0.f, 0.f};
#pragma unroll 16
            for (int k = wave * 256; k < wave * 256 + 256; ++k) { const f32x2 wv = *(const f32x2*)(W + (size_t)k * 12288); const LAS f32x4* sp = (const LAS f32x4*)(sc + k * 12); const f32x4 s0 = sp[0], s1 = sp[1], s2 = sp[2];
                acc[0] += s0.x * wv; acc[1] += s0.y * wv; acc[2] += s0.z * wv; acc[3] += s0.w * wv; acc[4] += s1.x * wv; acc[5] += s1.y * wv; acc[6] += s1.z * wv; acc[7] += s1.w * wv;
                acc[8] += s2.x * wv; acc[9] += s2.y * wv; acc[10] += s2.z * wv; acc[11] += s2.w * wv; }
#pragma unroll
            for (int s = 0; s < 12; ++s) *(LAS f32x2*)(part + (wave * 12 + s) * 128 + 2 * lane) = acc[s];
            __syncthreads();
            for (int o = tid; o < 12 * 128; o += 512) { const int s = o / 128, c = o % 128; float v = a.in[I_BADA][l * 12288 + n0 + c];
#pragma unroll
                for (int w = 0; w < 8; ++w) v += part[(w * 12 + s) * 128 + c];
                ((float*)(a.ws + WS_MOD))[(size_t)(l * NSEQ + s) * 12288 + n0 + c] = v; }
            __syncthreads();
        }
        __syncthreads();
    }
    {   LAS float* scr = (LAS float*)(lds + wave * L_TRS);
        const int gw = blockIdx.x * 8 + wave, NGW = G * 8;
        background_weights(a, -1, scr, gw, NGW, lane);
    }
    {   bf16* lup = (bf16*)(a.ws + WS_LUP);
        for (int e = blockIdx.x * 512 + tid; e < 4 * LUP_LAYER; e += G * 512) { const int l = e / LUP_LAYER, r = e % LUP_LAYER; float v;
            if (r < LUP_A2) { const int d = r >> 16, ch = (r & 65535) >> 6, k = r & 63; v = a.in[I_W2][((size_t)(l * 2 + d) * 64 + k) * 1024 + ch]; }
            else if (r < LUP_G2) { const int q = r - LUP_A2, d = q >> 16, ch = (q & 65535) >> 6, k = q & 63; v = a.in[I_A2][((size_t)(l * 2 + d) * 64 + k) * 1024 + ch]; }
            else if (r < LUP_V2) { const int q = r - LUP_G2, ch = q >> 6, k = q & 63; v = a.in[I_G2][((size_t)l * 64 + k) * 1024 + ch]; }
            else { const int q = r - LUP_V2, ch = q >> 5, k = q & 31; v = l > 0 ? a.in[I_V2][((size_t)(l - 1) * 32 + k) * 1024 + ch] : 0.f; }
            lup[e] = (bf16)f2bf(v); }
    }
}

DI void phase_resnorm(CArgs& a, LAS unsigned char* lds, int l, int mode, int tid, int lane, int wave, int G) {
    LAS float* prm = (LAS float*)(lds + L_PRM);
    const bf16* src = mode == 1 ? (const bf16*)(a.ws + WS_RBUF) : (const bf16*)(a.ws + WS_EX);
    bf16* hb = (bf16*)(a.ws + WS_HB);
    const bool do_h = (mode != 2) || (l < 3);
    const int ln = (mode == 2) ? l + 1 : l;
    const int rpb = (TOK + G - 1) / G, mb = min((int)blockIdx.x * rpb, TOK), me = min(mb + rpb, TOK);
    for (int m0 = mb; m0 < me; ) {
        int s, t0, T; tokinfo(m0, s, t0, T);
        const int mend = min(me, m0 - t0 + T);
        __syncthreads();
#pragma unroll
        for (int i = tid; i < D; i += 512) {
            float gpost = 0.f, gate = 0.f, gpre = 0.f, sc = 0.f, sh = 0.f;
            if (mode == 1) { gpost = a.in[I_GPOSTMIX][l * D + i]; gate = mod_ptr(a, l, s, 2)[i]; gpre = a.in[I_GPREFFN][l * D + i]; sc = mod_ptr(a, l, s, 4)[i]; sh = mod_ptr(a, l, s, 3)[i]; }
            else { if (mode == 2) { gpost = a.in[I_GPOSTFFN][l * D + i]; gate = mod_ptr(a, l, s, 5)[i]; }
                   if (do_h) { gpre = a.in[I_GPREMIX][ln * D + i]; sc = mod_ptr(a, ln, s, 1)[i]; sh = mod_ptr(a, ln, s, 0)[i]; } }
            prm[i] = gpost; prm[D + i] = gate; prm[2 * D + i] = gpre; prm[3 * D + i] = sc; prm[4 * D + i] = sh; }
        __syncthreads();
        const bool xin_f32 = (mode == 0) || (mode == 1 && l == 0);
        const bool xout_f32 = (mode == 2 && l == DEPTH - 1);
        bf16* xb = (bf16*)(a.ws + WS_XB);
#define RN_LOAD(mm_) do { if (xin_f32) { const float* xp_ = (mm_) < TP ? a.in[I_XP] + (size_t)(mm_) * D : a.in[I_XS] + (size_t)((mm_) - TP) * D; \
                _Pragma("unroll") for (int j = 0; j < 8; ++j) xn[j] = __builtin_nontemporal_load((const f32x4*)xp_ + lane + 64 * j); } \
            else { _Pragma("unroll") for (int j = 0; j < 8; ++j) { const u32x2 w_ = __builtin_nontemporal_load((const u32x2*)(xb + (size_t)(mm_) * D) + lane + 64 * j); xn[j] = (f32x4){bflo(w_.x), bfhi(w_.x), bflo(w_.y), bfhi(w_.y)}; } } \
            if (mode != 0) { _Pragma("unroll") for (int j = 0; j < 8; ++j) sn[j] = __builtin_nontemporal_load((const u32x2*)(src + (size_t)(mm_) * D + 4 * (lane + 64 * j))); } \
            if (mode == 1) { qn0 = *(const f32x4*)(ssqa + (size_t)(mm_) * 8); qn1 = *(const f32x4*)(ssqa + (size_t)(mm_) * 8 + 4); } } while (0)
        const float* ssqa = (const float*)(a.ws + WS_SSQ);
        f32x4 qn0 = (f32x4){0.f, 0.f, 0.f, 0.f}, qn1 = qn0;
        f32x4 xn[8]; u32x2 sn[8];
#pragma unroll
        for (int j = 0; j < 8; ++j) sn[j] = (u32x2){0u, 0u};
        if (m0 + wave < mend) RN_LOAD(m0 + wave);
#pragma unroll 1
        for (int m = m0 + wave; m < mend; m += 8) {
            f32x4 x[8]; u32x2 sv[8];
#pragma unroll
            for (int j = 0; j < 8; ++j) { x[j] = xn[j]; sv[j] = sn[j]; }
            const float eps1 = (mode == 1) ? NORM_EPS * (((qn0.x + qn0.y) + (qn0.z + qn0.w) + (qn1.x + qn1.y) + (qn1.z + qn1.w)) * (1.0f / 1024.0f) + NORM_EPS) : NORM_EPS;
            if (m + 8 < mend) RN_LOAD(m + 8);
            if (mode != 0) {
                f32x4 v[8]; float ss = 0.f;
#pragma unroll
                for (int j = 0; j < 8; ++j) { const u32x2 w = sv[j]; v[j] = (f32x4){bflo(w.x), bfhi(w.x), bflo(w.y), bfhi(w.y)};
                    ss += (v[j].x * v[j].x + v[j].y * v[j].y) + (v[j].z * v[j].z + v[j].w * v[j].w); }
                const float rstd = __builtin_amdgcn_rsqf(wave_sum_dpp(ss) * (1.0f / D) + eps1);
#pragma unroll
                for (int j = 0; j < 8; ++j) { const f32x4 gp = *(const LAS f32x4*)(prm + 4 * (lane + 64 * j)), gt = *(const LAS f32x4*)(prm + D + 4 * (lane + 64 * j));
                    x[j] = x[j] + gt * (v[j] * rstd * gp);
                    if (xout_f32) __builtin_nontemporal_store(x[j], (f32x4*)(a.out + (size_t)m * D) + lane + 64 * j);
                    else { u32x2 w; w.x = pk2(x[j].x, x[j].y); w.y = pk2(x[j].z, x[j].w); __builtin_nontemporal_store(w, (u32x2*)(xb + (size_t)m * D) + lane + 64 * j); } }
            }
            if (do_h) {
                float ss = 0.f;
#pragma unroll
                for (int j = 0; j < 8; ++j) ss += (x[j].x * x[j].x + x[j].y * x[j].y) + (x[j].z * x[j].z + x[j].w * x[j].w);
                const float rstd = __builtin_amdgcn_rsqf(wave_sum_dpp(ss) * (1.0f / D) + NORM_EPS);
#pragma unroll
                for (int j = 0; j < 8; ++j) { const int c = 4 * (lane + 64 * j); const f32x4 gp = *(const LAS f32x4*)(prm + 2 * D + c), sc = *(const LAS f32x4*)(prm + 3 * D + c), sh = *(const LAS f32x4*)(prm + 4 * D + c);
                    const f32x4 h = x[j] * rstd * gp * (1.0f + sc) + sh; u32x2 w; w.x = pk2(h.x, h.y); w.y = pk2(h.z, h.w); *(u32x2*)(hb + (size_t)m * D + c) = w;
                    if ((j & 1) == 1) asm volatile("" ::: "memory"); }
            }
        }
#undef RN_LOAD
        m0 = mend;
    }
}
#define MFMA32(a, b, c) __builtin_amdgcn_mfma_f32_32x32x16_bf16((a), (b), (c), 0, 0, 0)
DI int v_off(int row, int ch) { return 256 * row + 16 * (ch ^ (((row & 3) << 2) | ((row >> 2) & 3))); }
DI s16x4 tr_read(const LAS unsigned char* p) { return __builtin_amdgcn_ds_read_tr16_b64_v4i16((LAS s16x4*)p); }
DI bf16x8 pack8(const f32x16& x, int s) {
    u32x4 p; p.x = pk2(x[8 * s + 0], x[8 * s + 1]); p.y = pk2(x[8 * s + 2], x[8 * s + 3]); p.z = pk2(x[8 * s + 4], x[8 * s + 5]); p.w = pk2(x[8 * s + 6], x[8 * s + 7]);
    return __builtin_bit_cast(bf16x8, p);
}
template <int V> struct IntC { static constexpr int value = V; };
template <int QH>
DI void att_tile(f32x16 (&o)[4], float& mrun, float& lrun, const LAS unsigned char* kt, const LAS unsigned char* vt, const LAS unsigned char* qt, const int (&vofs)[4][2],
                 const LAS float* bp, int dv, int rq, int h, float scale) {
    constexpr int FB = 1 - QH, NB = QH, FV0 = QH ? 12 : 0, FS2 = QH ? 1 : 0;
#define LIVE(kb_, i_) ((kb_) == NB || ((i_) >= FV0 && (i_) < FV0 + 4))
    f32x16 st[2];
#pragma unroll
    for (int kb = 0; kb < 2; ++kb)
#pragma unroll
        for (int i = 0; i < 16; ++i) st[kb][i] = 0.f;
    bf16x8 qf[8], kf[8][2];
#define QK_LOAD(ks_) do { qf[ks_] = *(const LAS bf16x8*)(qt + v_off(rq, 2 * (ks_) + h)); kf[ks_][0] = *(const LAS bf16x8*)(kt + v_off(rq, 2 * (ks_) + h)); kf[ks_][1] = *(const LAS bf16x8*)(kt + v_off(32 + rq, 2 * (ks_) + h)); } while (0)
    __builtin_amdgcn_sched_barrier(0);
    QK_LOAD(0);
    __builtin_amdgcn_sched_barrier(0);
#pragma unroll
    for (int ks = 0; ks < 8; ++ks) {
        st[0] = MFMA32(kf[ks][0], qf[ks], st[0]); st[1] = MFMA32(kf[ks][1], qf[ks], st[1]);
        if (ks + 1 < 8) QK_LOAD(ks + 1);
        __builtin_amdgcn_sched_barrier(0); }
#undef QK_LOAD
    bf16x8 vf[12];
#define PV_KB(g_) (((g_) >> 2) == 2 ? FB : NB)
#define PV_S2(g_) (((g_) >> 2) == 2 ? FS2 : ((g_) >> 2))
#define PV_LOAD(g_) do { const int kb_ = PV_KB(g_), s2_ = PV_S2(g_), db_ = (g_) & 3; \
        const s16x4 lo_ = tr_read(vt + vofs[db_][0] + 256 * (32 * kb_ + 16 * s2_)), hi_ = tr_read(vt + vofs[db_][1] + 256 * (32 * kb_ + 16 * s2_)); \
        vf[g_] = __builtin_shufflevector(lo_, hi_, 0, 1, 2, 3, 4, 5, 6, 7); } while (0)
    PV_LOAD(0); PV_LOAD(1);
    __builtin_amdgcn_sched_barrier(0);
    float mx = -1e30f;
#pragma unroll
    for (int kb = 0; kb < 2; ++kb) {
        float bv[16];
#pragma unroll
        for (int i = 0; i < 16; ++i) bv[i] = LIVE(kb, i) ? bp[32 * kb + (i & 3) + 8 * (i >> 2)] : 0.f;
#pragma unroll
        for (int i = 0; i < 16; ++i) if (LIVE(kb, i)) { const int cc = 32 * kb + (i & 3) + 8 * (i >> 2); const bool valid = (unsigned)(cc + dv) < 16u;
            const float sb = fmaf(st[kb][i], scale, bv[i]); const float sv2 = valid ? sb : -1e30f; st[kb][i] = sv2; mx = fmaxf(mx, sv2); }
        __builtin_amdgcn_sched_barrier(0); }
    mx = fmaxf(mx, __shfl_xor(mx, 32));
    const float mnew = fmaxf(mrun, mx), alpha = __builtin_amdgcn_exp2f(mrun - mnew);
    float psum = 0.f;
#pragma unroll
    for (int kb = 0; kb < 2; ++kb)
#pragma unroll
        for (int i = 0; i < 16; ++i) { if (LIVE(kb, i)) { const float p = __builtin_amdgcn_exp2f(st[kb][i] - mnew); st[kb][i] = p; psum += p; } else st[kb][i] = 0.f; }
    lrun = lrun * alpha + psum; mrun = mnew;
#pragma unroll
    for (int db = 0; db < 4; ++db)
#pragma unroll
        for (int i = 0; i < 16; ++i) o[db][i] *= alpha;
    __builtin_amdgcn_sched_barrier(0);
#pragma unroll
    for (int g = 0; g < 12; ++g) { const bf16x8 pf = pack8(st[PV_KB(g)], PV_S2(g));
        o[g & 3] = MFMA32(vf[g], pf, o[g & 3]);
        if (g + 2 < 12) PV_LOAD(g + 2);
        __builtin_amdgcn_sched_barrier(0); }
#undef PV_LOAD
#undef PV_KB
#undef PV_S2
#undef LIVE
}
DI void phase_attention(CArgs& a, LAS unsigned char* lds, int l, int tid, int lane, int wave, int G) {
    const bf16* qkv = (const bf16*)(a.ws + WS_QKV);
    bf16* mixin = (bf16*)(a.ws + WS_MIXIN);
    float* ssqo = (float*)(a.ws + WS_SSQ);
    LAS float* bt = (LAS float*)(lds + L_BIAS);
    const int rq = lane & 31, h = lane >> 5;
    const float scale = 0.08838834764831845f * 1.4426950408889634f;
    int vofs[4][2];
    { const int g16 = lane & 15, qq = g16 >> 2, pp = g16 & 3, blk = (lane >> 4) & 1;
#pragma unroll
      for (int db = 0; db < 4; ++db)
#pragma unroll
          for (int hi = 0; hi < 2; ++hi) vofs[db][hi] = v_off(4 * h + qq + 8 * hi, 4 * db + 2 * blk + (pp >> 1)) + 8 * (pp & 1); }
    const int skey0 = tid >> 4, sch = tid & 15;
    for (int u = blockIdx.x; u < (TOK / 256) * NAH; u += G) {
        const int head = u & 7, m0 = (u >> 3) * 256; int s, t0, T; tokinfo(m0, s, t0, T);
        const int r0 = t0 >> 6, rows = T >> 6, sbase = m0 - t0;
        const int r = r0 + (wave >> 1), qh = wave & 1;
        const int rs = min(max(r - 4, 0), rows - 8);
        const int klo = min(max(r0 - 4, 0), rows - 8), khi = min(max(r0 + 3 - 4, 0), rows - 8) + 8, nt = khi - klo;
        const int q = 32 * qh + rq, mq = m0 + 64 * (wave >> 1) + q;
        const int cs = min(max(q - 8, 0), 48);
        __syncthreads();
        LAS unsigned char* qt = lds + 65536 + wave * 8192;
        u32x4 sk[2][2], sv[2][2];
#define KV_FETCH(set_, row_) do { const bf16* kp_ = qkv + (size_t)(sbase + (row_) * 64 + skey0) * NQKV + head * 128 + sch * 8; \
            _Pragma("unroll") for (int i_ = 0; i_ < 2; ++i_) { sk[set_][i_] = *(const u32x4*)(kp_ + (size_t)(32 * i_) * NQKV + 1024); sv[set_][i_] = *(const u32x4*)(kp_ + (size_t)(32 * i_) * NQKV + 2048); } } while (0)
        {   const float bias_v = a.in[I_RPB][(size_t)(l * NAH + head) * 465 + min(tid, 15 * 31 - 1)];
            u32x4 qreg[8];
            const bf16* qp = qkv + (size_t)(m0 + 64 * (wave >> 1) + 32 * qh) * NQKV + head * 128;
#pragma unroll
            for (int i = 0; i < 8; ++i) { const int p = i * 64 + lane, row = p >> 4, ch = p & 15; qreg[i] = *(const u32x4*)(qp + (size_t)row * NQKV + ch * 8); }
            KV_FETCH(0, klo);
            KV_FETCH(1, klo + 1);
            __builtin_amdgcn_sched_barrier(0);
            if (tid < 15 * 31) bt[tid] = 1.4426950408889634f * bias_v;
#pragma unroll
            for (int i = 0; i < 8; ++i) { const int p = i * 64 + lane, row = p >> 4, ch = p & 15; *(LAS u32x4*)(qt + v_off(row, ch)) = qreg[i]; }
#pragma unroll
            for (int i = 0; i < 2; ++i) { *(LAS u32x4*)(lds + v_off(skey0 + 32 * i, sch)) = sk[0][i]; *(LAS u32x4*)(lds + 16384 + v_off(skey0 + 32 * i, sch)) = sv[0][i]; }
        }
        f32x16 o[4];
#pragma unroll
        for (int db = 0; db < 4; ++db)
#pragma unroll
            for (int i = 0; i < 16; ++i) o[db][i] = 0.f;
        float mrun = -1e30f, lrun = 0.f;
        __syncthreads();
        auto tile_loop = [&](auto qhc) __attribute__((always_inline)) {
        constexpr int QH = decltype(qhc)::value;
#pragma unroll 1
        for (int it0 = 0; it0 < nt; it0 += 2) {
#pragma unroll
        for (int half = 0; half < 2; ++half) {
            const int it = it0 + half; if (it >= nt) break;
            const int R = klo + it;
            LAS unsigned char* kt = lds + half * 32768; LAS unsigned char* vt = kt + 16384;
            if (it + 2 < nt) KV_FETCH(half, R + 2);
            if (R >= rs && R < rs + 8) {
                int dv = 4 * h - cs; asm volatile("" : "+v"(dv));
                const LAS float* bp = bt + (R - r + 7) * 31 + (4 * h - q + 15);
                att_tile<QH>(o, mrun, lrun, kt, vt, qt, vofs, bp, dv, rq, h, scale);
            }
            if (it + 1 < nt) { LAS unsigned char* kn = lds + (1 - half) * 32768;
#pragma unroll
                for (int i = 0; i < 2; ++i) { *(LAS u32x4*)(kn + v_off(skey0 + 32 * i, sch)) = sk[1 - half][i]; *(LAS u32x4*)(kn + 16384 + v_off(skey0 + 32 * i, sch)) = sv[1 - half][i]; } }
            __syncthreads();
        } }
        };
        if (qh == 0) tile_loop(IntC<0>{}); else tile_loop(IntC<1>{});
#undef KV_FETCH
        const float inv = 1.0f / (lrun + __shfl_xor(lrun, 32));
        float ss = 0.f;
#pragma unroll
        for (int db = 0; db < 4; ++db)
#pragma unroll
            for (int i = 0; i < 16; ++i) { o[db][i] *= inv; ss += o[db][i] * o[db][i]; }
        ss += __shfl_xor(ss, 32);
        if (lane < 32) ssqo[(size_t)mq * NAH + head] = ss;
        {   LAS unsigned char* ost = lds + wave * 16384;
#pragma unroll
            for (int db = 0; db < 4; ++db)
#pragma unroll
                for (int g4 = 0; g4 < 4; ++g4) { const int d0 = 32 * db + 8 * g4 + 4 * h;
                    u32x2 w; w.x = pk2(o[db][4 * g4 + 0], o[db][4 * g4 + 1]); w.y = pk2(o[db][4 * g4 + 2], o[db][4 * g4 + 3]);
                    *(LAS u32x2*)(ost + rq * 272 + d0 * 2) = w; }
            bf16* obase = mixin + (size_t)(m0 + 64 * (wave >> 1) + 32 * qh) * D + head * 128;
            u32x4 orow[8];
#pragma unroll
            for (int i = 0; i < 8; ++i) { const int p = i * 64 + lane, row = p >> 4, ch = p & 15; orow[i] = *(const LAS u32x4*)(ost + row * 272 + ch * 16); }
            __builtin_amdgcn_sched_barrier(0);
#pragma unroll
            for (int i = 0; i < 8; ++i) { const int p = i * 64 + lane, row = p >> 4, ch = p & 15; *(u32x4*)(obase + (size_t)row * D + ch * 8) = orow[i]; }
        }
    }
}
#define MFMA16(a, b, c) __builtin_amdgcn_mfma_f32_16x16x32_bf16((a), (b), (c), 0, 0, 0)
constexpr int ACT_LD = 360;
constexpr int PP_OFF = 46080;
enum { PP_MUR0 = 0, PP_MUR1, PP_MUK0, PP_MUK1, PP_MUV0, PP_MUV1, PP_W00, PP_W01, PP_A00, PP_A01, PP_V0, PP_KK, PP_KA, PP_RK };
DI void phase_prep(CArgs& a, LAS unsigned char* lds, int l, int tid, int lane, int wave, int G) {
    const bf16* rcg = (const bf16*)(a.ws + WS_RBUF);
    const bf16* lb = (const bf16*)(a.ws + WS_LORA);
    LAS bf16* act = (LAS bf16*)lds;
    LAS float* prm = (LAS float*)(lds + PP_OFF);
    const bf16* lup = (const bf16*)(a.ws + WS_LUP) + (size_t)l * LUP_LAYER;
    unsigned short* o_r = (unsigned short*)(a.ws + WS_QKV); unsigned short* o_k = o_r + PLANE; unsigned short* o_v = o_k + PLANE;
    unsigned short* o_lw = (unsigned short*)(a.ws + WS_HB);
    unsigned short* o_a = (unsigned short*)(a.ws + WS_EX);
    unsigned short* o_g = (unsigned short*)(a.ws + WS_G);
    unsigned short* vfirst = (unsigned short*)(a.ws + WS_VFIRST);
    float* o_kn = (float*)(a.ws + WS_KN); float* o_bon = o_kn + (size_t)TOK * 16;
    const int fr = lane & 15, fq = lane >> 4;
    __syncthreads();
    {
        float pv[28];
#pragma unroll
        for (int k = 0; k < 28; ++k) { const int v = k >> 1, c = tid + 512 * (k & 1); float x;
            if (v < 6) x = a.in[I_MURKV][(size_t)(l * 3 + (v >> 1)) * 2048 + (v & 1) * 1024 + c];
            else if (v < 8) x = a.in[I_W0][(size_t)l * 2048 + (v - 6) * 1024 + c];
            else if (v < 10) x = a.in[I_A0][(size_t)l * 2048 + (v - 8) * 1024 + c];
            else if (v == 10) x = a.in[I_V0][(size_t)max(l - 1, 0) * 1024 + c];
            else if (v == 11) x = a.in[I_KK][(size_t)l * 1024 + c];
            else if (v == 12) x = a.in[I_KA][(size_t)l * 1024 + c];
            else x = a.in[I_RK][(size_t)l * 1024 + c];
            pv[k] = x; }
        __builtin_amdgcn_sched_barrier(0);
#pragma unroll
        for (int k = 0; k < 28; ++k) { const int v = k >> 1, c = tid + 512 * (k & 1); prm[v * 1024 + c] = (v == 10 && l == 0) ? 0.f : pv[k]; }
    }
    for (int tile = blockIdx.x; tile < TOK / 32; tile += G) {
        const int m0 = tile * 32; int s, t0, T; tokinfo(m0, s, t0, T);
        __syncthreads();
        {
            u32x4 aw[3], awp[3], awn[3];
#pragma unroll
            for (int k = 0; k < 3; ++k) { const int it = min(tid + 512 * k, 32 * 44 - 1), i = it / 44, c = 8 * (it % 44), m = m0 + i, t = t0 + i;
                const bf16* p0 = lb + (size_t)m * NLB + c;
                aw[k] = *(const u32x4*)p0; awp[k] = *(const u32x4*)(p0 + (t > 0 ? -NLB : 0) + LORA); awn[k] = *(const u32x4*)(p0 + (t < T - 1 ? NLB : 0) + 2 * LORA); }
            __builtin_amdgcn_sched_barrier(0);
#pragma unroll
            for (int k = 0; k < 3; ++k) { const int it = tid + 512 * k; if (it < 32 * 44) { const int i = it / 44, c = 8 * (it % 44), t = t0 + i;
                const u32x4 w = aw[k], wp = awp[k], wn = awn[k];
                const float pm = t > 0 ? 1.f : 0.f, nm = t < T - 1 ? 1.f : 0.f;
                float v[8];
#pragma unroll
                for (int j = 0; j < 4; ++j) { v[2 * j] = bflo(w[j]) + pm * bflo(wp[j]) + nm * bflo(wn[j]); v[2 * j + 1] = bfhi(w[j]) + pm * bfhi(wp[j]) + nm * bfhi(wn[j]); }
                if (c < 128) {
#pragma unroll
                    for (int j = 0; j < 8; ++j) v[j] = tanhf_(v[j]); }
                else if (c >= 256 && c < 320) {
#pragma unroll
                    for (int j = 0; j < 8; ++j) v[j] = sigmoidf_(v[j]); }
                u32x4 ow; ow.x = pkbf(v[0], v[1]); ow.y = pkbf(v[2], v[3]); ow.z = pkbf(v[4], v[5]); ow.w = pkbf(v[6], v[7]);
                *(LAS u32x4*)(act + i * ACT_LD + c) = ow; } }
        }
        __syncthreads();
        LAS float* hpart = (LAS float*)(lds + PP_OFF + 57344) + wave * 192;
#pragma unroll 1
        for (int hc = 0; hc < 4; ++hc) {
            const int hp = hc >> 1, cgl = hc & 1, cg = hc;
            const int cbase = 128 * wave + 32 * cg, c0 = cbase + 8 * fq;
            const int wrow0 = cbase + 8 * (fr >> 2) + (fr & 3);
            bf16x8 wf[6][2][2];
#pragma unroll
            for (int mm = 0; mm < 6; ++mm) { const bf16* wt = lup + (mm < 2 ? LUP_W2 + mm * 65536 : mm < 4 ? LUP_A2 + (mm - 2) * 65536 : mm == 4 ? LUP_G2 : LUP_V2); const int kw = (mm == 5) ? 32 : 64;
#pragma unroll
                for (int ks = 0; ks < (mm == 5 ? 1 : 2); ++ks)
#pragma unroll
                    for (int n = 0; n < 2; ++n) wf[mm][ks][n] = *(const bf16x8*)(wt + (size_t)(wrow0 + 4 * n) * kw + 32 * ks + 8 * fq); }
#pragma unroll 1
            for (int tb = 0; tb < 2; ++tb) {
            const int i = 16 * tb + fr, m = m0 + i, t = t0 + i;
            u32x4 cur[10];
            const size_t ob = ((size_t)(4 * wave + cg) * TOK + m) * 32 + 8 * fq;
            {   const bf16* rp_ = rcg + ob; const int tp_ = t > 0 ? -32 : 0, tn_ = t < T - 1 ? 32 : 0;
                cur[0] = *(const u32x4*)rp_; cur[1] = *(const u32x4*)(rp_ + PLANE); cur[2] = *(const u32x4*)(rp_ + 2 * PLANE);
                cur[3] = *(const u32x4*)(rp_ + tp_); cur[4] = *(const u32x4*)(rp_ + tp_ + PLANE); cur[5] = *(const u32x4*)(rp_ + tp_ + 2 * PLANE);
                cur[6] = *(const u32x4*)(rp_ + tn_); cur[7] = *(const u32x4*)(rp_ + tn_ + PLANE); cur[8] = *(const u32x4*)(rp_ + tn_ + 2 * PLANE);
                cur[9] = l > 0 ? __builtin_nontemporal_load((const u32x4*)(vfirst + ob)) : (u32x4){0u, 0u, 0u, 0u}; }
            float pss = 0.f, pb0 = 0.f, pb1 = 0.f;
            const LAS bf16* arow = act + i * ACT_LD + 8 * fq;
#define LUP(name, mm) f32x4 name[2] = {(f32x4){0.f, 0.f, 0.f, 0.f}, (f32x4){0.f, 0.f, 0.f, 0.f}}; { _Pragma("unroll") for (int ks_ = 0; ks_ < ((mm) == 5 ? 1 : 2); ++ks_) { const bf16x8 af_ = *(const LAS bf16x8*)(arow + 64 * (mm) + 32 * ks_); \
                _Pragma("unroll") for (int n_ = 0; n_ < 2; ++n_) name[n_] = MFMA16(wf[mm][ks_][n_], af_, name[n_]); } }
            const LAS float* pp = prm + c0;
#define PRM8(name, vi_) float name[8]; { const f32x4 x0_ = *(const LAS f32x4*)(pp + (vi_) * 1024), x1_ = *(const LAS f32x4*)(pp + (vi_) * 1024 + 4); \
                name[0] = x0_[0]; name[1] = x0_[1]; name[2] = x0_[2]; name[3] = x0_[3]; name[4] = x1_[0]; name[5] = x1_[1]; name[6] = x1_[2]; name[7] = x1_[3]; }
#define BF8(dst, src, msk) float dst[8]; { _Pragma("unroll") for (int j_ = 0; j_ < 4; ++j_) { dst[2 * j_] = (msk) * bflo(src[j_]); dst[2 * j_ + 1] = (msk) * bfhi(src[j_]); } }
#define ST8H(ptr, arr_) do { u32x4 w_; w_[0] = pkh2(arr_[0], arr_[1]); w_[1] = pkh2(arr_[2], arr_[3]); w_[2] = pkh2(arr_[4], arr_[5]); w_[3] = pkh2(arr_[6], arr_[7]); __builtin_nontemporal_store(w_, (u32x4*)(ptr)); } while (0)
            const float pm = t > 0 ? 1.f : 0.f, nm = t < T - 1 ? 1.f : 0.f;
            float rr[8], kk[8];
            {   PRM8(m0_, PP_MUR0) PRM8(m1_, PP_MUR1) BF8(c_, cur[0], 1.f) BF8(p_, cur[3], pm) BF8(n_, cur[6], nm)
#pragma unroll
                for (int j = 0; j < 8; ++j) rr[j] = c_[j] + m0_[j] * (p_[j] - c_[j]) + m1_[j] * (n_[j] - c_[j]);
                ST8H(o_r + ob, rr); }
            {   PRM8(m0_, PP_MUK0) PRM8(m1_, PP_MUK1) BF8(c_, cur[1], 1.f) BF8(p_, cur[4], pm) BF8(n_, cur[7], nm)
#pragma unroll
                for (int j = 0; j < 8; ++j) kk[j] = c_[j] + m0_[j] * (p_[j] - c_[j]) + m1_[j] * (n_[j] - c_[j]);
                ST8H(o_k + ob, kk); }
            {   float vv[8]; PRM8(m0_, PP_MUV0) PRM8(m1_, PP_MUV1) BF8(c_, cur[2], 1.f) BF8(p_, cur[5], pm) BF8(n_, cur[8], nm)
#pragma unroll
                for (int j = 0; j < 8; ++j) vv[j] = c_[j] + m0_[j] * (p_[j] - c_[j]) + m1_[j] * (n_[j] - c_[j]);
                if (l == 0) { ST8H(vfirst + ob, vv); }
                else { PRM8(v0_, PP_V0) LUP(accv, 5)
#pragma unroll
                    for (int j = 0; j < 8; ++j) { const float f = (j & 1) ? hhi(cur[9][j >> 1]) : hlo(cur[9][j >> 1]); const float gte = sigmoidf_(v0_[j] + accv[j >> 2][j & 3]); vv[j] = vv[j] + (f - vv[j]) * gte; } }
                ST8H(o_v + ob, vv); }
            {   PRM8(ka_, PP_KA) PRM8(rk_, PP_RK)
#pragma unroll
                for (int d = 0; d < 2; ++d) { float lw[8], av[8]; PRM8(w0_, PP_W00 + d) PRM8(a0_, PP_A00 + d) LUP(accw, d) LUP(acca, 2 + d)
#pragma unroll
                    for (int j = 0; j < 8; ++j) { lw[j] = -0.6065306597126334f * sigmoidf_(w0_[j] + accw[j >> 2][j & 3]); av[j] = sigmoidf_(a0_[j] + acca[j >> 2][j & 3]);
                        const float pbv = rr[j] * (kk[j] * (1.0f + (av[j] - 1.0f) * ka_[j])) * rk_[j]; if (d == 0) pb0 += pbv; else pb1 += pbv; }
                    ST8H(o_lw + (size_t)d * PLANE + ob, lw); ST8H(o_a + (size_t)d * PLANE + ob, av); } }
            { LUP(accg, 4) u32x4 w; w.x = pkh2(accg[0][0], accg[0][1]); w.y = pkh2(accg[0][2], accg[0][3]); w.z = pkh2(accg[1][0], accg[1][1]); w.w = pkh2(accg[1][2], accg[1][3]);
              __builtin_nontemporal_store(w, (u32x4*)(o_g + ob)); }
            {   PRM8(kkp_, PP_KK)
#pragma unroll
                for (int j = 0; j < 8; ++j) { const float x = kk[j] * kkp_[j]; pss += x * x; } }
#undef PRM8
#undef BF8
#undef ST8H
#undef LUP
            {   float q0 = pss, q1 = pb0, q2 = pb1;
                q0 += __shfl_xor(q0, 16); q0 += __shfl_xor(q0, 32); q1 += __shfl_xor(q1, 16); q1 += __shfl_xor(q1, 32); q2 += __shfl_xor(q2, 16); q2 += __shfl_xor(q2, 32);
                LAS float* hq = hpart + (tb * 16 + fr) * 3;
                if (cgl == 0) { if (lane < 16) { hq[0] = q0; hq[1] = q1; hq[2] = q2; } }
                else if (lane < 16) { q0 += hq[0]; q1 += hq[1]; q2 += hq[2];
                    const size_t o = (size_t)m * 16 + 2 * wave + hp; o_kn[o] = __builtin_amdgcn_rsqf(fmaxf(q0, 1e-24f)); o_bon[o] = q1; o_bon[(size_t)TOK * 16 + o] = q2; } }
            }
        }
    }
}

constexpr int NAT_LD = 144, NAT_ARR = 32 * NAT_LD, CHM_LD = 80, CHM_ARR = 64 * CHM_LD;
constexpr int NAT_ALL = 4 * NAT_ARR, CHM_ALL = 4 * CHM_ARR, NC_BUF = NAT_ALL + CHM_ALL;
constexpr int O_RAW = 0, O_BUF = 20480;
template <int DB> struct SlotMap { static constexpr int O_SM = O_BUF + DB * NC_BUF, O_FLAG = O_SM + DB * 512, BYTES = O_FLAG + 64; };
constexpr int SLOT0 = SlotMap<2>::BYTES, SLOT1 = SlotMap<1>::BYTES;
enum { F_RAW = 0, F_ST0 = 1, F_ST1 = 2, F_CONS = 3, F_CP1 = 4 };
DI bf16x8 packc(const f32x16& x, int s) { u32x4 p; p.x = pkbf(x[8 * s + 0], x[8 * s + 1]); p.y = pkbf(x[8 * s + 2], x[8 * s + 3]); p.z = pkbf(x[8 * s + 4], x[8 * s + 5]); p.w = pkbf(x[8 * s + 6], x[8 * s + 7]); return __builtin_bit_cast(bf16x8, p); }
DI void spin_ge(volatile LAS unsigned* f, unsigned v) { unsigned sp = 0; while (*f < v && ++sp < (1u << 24)) __builtin_amdgcn_s_sleep(1); asm volatile("" ::: "memory"); }
DI bf16x8 ld_perm(const LAS unsigned char* row, int s, int h) {
    const s16x4 lo = *(const LAS s16x4*)(row + 2 * (16 * s + 4 * h)), hi = *(const LAS s16x4*)(row + 2 * (16 * s + 8 + 4 * h));
    return __builtin_shufflevector(lo, hi, 0, 1, 2, 3, 4, 5, 6, 7);
}
DI void scan_dma(const unsigned short* const (&src)[5], LAS unsigned char* raw, size_t tokoff, int d, int lane) {
    int tl = lane >> 3, pc = (lane & 7) * 8; asm volatile("" : "+v"(tl), "+v"(pc));
#pragma unroll
    for (int rg = 0; rg < 4; ++rg) { const int R = 8 * rg + tl; const size_t lo = ((size_t)(pc >> 5) * TOK + tokoff + (size_t)(d ? 31 - R : R)) * 32 + (pc & 31);
#pragma unroll
        for (int arr = 0; arr < 5; ++arr)
            __builtin_amdgcn_global_load_lds((const unsigned*)(src[arr] + lo), (LAS unsigned*)(raw + (arr * 32 + rg * 8) * 128), 16, 0, 0); }
}
struct StageRaw { unsigned short xr[8], xk[8], xv[8], xl[8], xa[8]; };
DI void stage_load(const LAS unsigned char* raw, int lane, int o, StageRaw& X) {
    const LAS unsigned short* ro = (const LAS unsigned short*)raw + lane + (8 * o) * 64;
#pragma unroll
    for (int e8 = 0; e8 < 8; ++e8) { X.xr[e8] = ro[(0 * 32 + e8) * 64]; X.xk[e8] = ro[(1 * 32 + e8) * 64]; X.xv[e8] = ro[(2 * 32 + e8) * 64]; X.xl[e8] = ro[(3 * 32 + e8) * 64]; X.xa[e8] = ro[(4 * 32 + e8) * 64]; }
}
DI float stage_compute(const StageRaw& X, LAS unsigned char* nat, LAS unsigned char* chm, const LAS float* kns, int lane, int o, float E, float kkc, float kac) {
    const f32x4 kn0 = *(const LAS f32x4*)(kns + 8 * o), kn1 = *(const LAS f32x4*)(kns + 8 * o + 4);
    unsigned pa[4][4];
    float ha[4] = {0.f, 0.f, 0.f, 0.f};
    LAS unsigned short* npo = (LAS unsigned short*)(nat + (8 * o) * NAT_LD) + lane;
#pragma unroll
    for (int e8 = 0; e8 < 8; ++e8) {
        const float r = h2f(X.xr[e8]), k = h2f(X.xk[e8]), v = h2f(X.xv[e8]), lw = h2f(X.xl[e8]), av = h2f(X.xa[e8]);
        const float Ep = E; E = E * __expf(lw); const float iE = __builtin_amdgcn_rcpf(E);
        const float kkn = k * kkc * (e8 < 4 ? kn0[e8 & 3] : kn1[e8 & 3]);
        const float kd = k * (1.0f + (av - 1.0f) * kac);
        const float bvec = kkn * av, at = -kkn * Ep, bh = bvec * iE, kh = kd * iE, rt = r * E;
        const unsigned w01 = pkbf(bh, kh), w23 = pkbf(at, rt);
        LAS unsigned short* np_ = npo + e8 * (NAT_LD / 2);
        np_[0] = (unsigned short)w01; np_[NAT_ARR / 2] = (unsigned short)(w01 >> 16); np_[2 * (NAT_ARR / 2)] = (unsigned short)w23; np_[3 * (NAT_ARR / 2)] = (unsigned short)(w23 >> 16);
        if ((e8 & 1) == 0) { ha[0] = at; ha[1] = v; ha[2] = bh; ha[3] = kh; }
        else { pa[0][e8 >> 1] = pkbf(ha[0], at); pa[1][e8 >> 1] = pkbf(ha[1], v); pa[2][e8 >> 1] = pkbf(ha[2], bh); pa[3][e8 >> 1] = pkbf(ha[3], kh); }
    }
#pragma unroll
    for (int ar = 0; ar < 4; ++ar) *(LAS u32x4*)(chm + ar * CHM_ARR + lane * CHM_LD + 16 * o) = (u32x4){pa[ar][0], pa[ar][1], pa[ar][2], pa[ar][3]};
    return E;
}
DI void scan_decode(int unit, int& s, int& hh, int& d) { if (unit < 256) { s = unit >> 5; hh = (unit >> 1) & 15; d = unit & 1; } else { const int uu = unit - 256; s = 8 + (uu >> 5); hh = (uu >> 1) & 15; d = uu & 1; } }
template <int DB> DI void scan_helper(CArgs& a, LAS unsigned char* sm, int l, int unit, int lane, int hsel) {
    int s, hh, d; scan_decode(unit, s, hh, d);
    const int T = seq_len(s), mbase = seq_start(s), ch = hh * 64 + lane, nchunk = T >> 5;
    const unsigned short* i_r = (const unsigned short*)(a.ws + WS_QKV);
    const unsigned short* const src[5] = {i_r, i_r + PLANE, i_r + 2 * PLANE, (const unsigned short*)(a.ws + WS_HB) + (size_t)d * PLANE, (const unsigned short*)(a.ws + WS_EX) + (size_t)d * PLANE};
    const float* g_kn = (const float*)(a.ws + WS_KN) + hh; const float* g_bon = g_kn + (size_t)(1 + d) * TOK * 16;
    const float kkc = a.in[I_KK][l * 1024 + ch], kac = a.in[I_KA][l * 1024 + ch];
    asm volatile("" : "+s"(sm));
    LAS unsigned char* raw = sm + O_RAW;
    volatile LAS unsigned* flg = (volatile LAS unsigned*)(sm + SlotMap<DB>::O_FLAG);
    float knv = 0.f, bnv = 0.f;
    if (hsel == 0) { scan_dma(src, raw, (size_t)2 * hh * TOK + (size_t)(mbase + (d ? T - 32 : 0)), d, lane);
        const size_t o = (size_t)(mbase + (d ? T - 1 - (lane & 31) : (lane & 31))) * 16; knv = g_kn[o]; bnv = g_bon[o];
        asm volatile("s_waitcnt vmcnt(0)" ::: "memory"); }
#pragma unroll 1
    for (int n = 0; n < nchunk; ++n) {
        const int b = (DB == 2) ? (n & 1) : 0;
        LAS unsigned char* nat = sm + O_BUF + b * NC_BUF; LAS unsigned char* chm = nat + NAT_ALL;
        LAS float* ecv = (LAS float*)(sm + SlotMap<DB>::O_SM + b * 512); LAS float* bon = ecv + 64; LAS float* kns = ecv + 96;
        if (hsel == 0) {
            if (n + 1 > DB) spin_ge(flg + F_CONS, (unsigned)(n + 1 - DB));
            { int ln = lane; asm volatile("" : "+v"(ln)); if (ln < 32) { kns[ln] = knv; bon[ln] = bnv; } }
            asm volatile("s_waitcnt lgkmcnt(0)" ::: "memory");
            if (lane == 0) flg[F_RAW] = (unsigned)(n + 1);
            StageRaw X0, X1; stage_load(raw, lane, 0, X0); stage_load(raw, lane, 1, X1);
            asm volatile("s_waitcnt lgkmcnt(0)" ::: "memory");
            spin_ge(flg + F_CP1, (unsigned)(n + 1));
            if (n + 1 < nchunk) { scan_dma(src, raw, (size_t)2 * hh * TOK + (size_t)(mbase + (d ? T - 32 * (n + 2) : 32 * (n + 1))), d, lane);
                const size_t o = (size_t)(mbase + (d ? T - 32 * (n + 1) - 1 - (lane & 31) : 32 * (n + 1) + (lane & 31))) * 16; knv = g_kn[o]; bnv = g_bon[o]; }
            { float E = stage_compute(X0, nat, chm, kns, lane, 0, 1.0f, kkc, kac); __builtin_amdgcn_sched_barrier(0); (void)stage_compute(X1, nat, chm, kns, lane, 1, E, kkc, kac); }
            asm volatile("s_waitcnt lgkmcnt(0)" ::: "memory");
            if (lane == 0) flg[F_ST0] = (unsigned)(n + 1);
            asm volatile("s_waitcnt vmcnt(0)" ::: "memory");
        } else {
            spin_ge(flg + F_RAW, (unsigned)(n + 1));
            const LAS unsigned short* rw = (const LAS unsigned short*)raw + lane;
            float lam = 0.f; unsigned short xl[16];
#pragma unroll
            for (int t = 0; t < 16; ++t) xl[t] = rw[(3 * 32 + t) * 64];
            StageRaw X2, X3; stage_load(raw, lane, 2, X2); stage_load(raw, lane, 3, X3);
            asm volatile("s_waitcnt lgkmcnt(0)" ::: "memory");
            if (lane == 0) flg[F_CP1] = (unsigned)(n + 1);
#pragma unroll
            for (int t = 0; t < 16; ++t) lam += h2f(xl[t]);
            float E = stage_compute(X2, nat, chm, kns, lane, 2, __expf(lam), kkc, kac); __builtin_amdgcn_sched_barrier(0); E = stage_compute(X3, nat, chm, kns, lane, 3, E, kkc, kac);
            ecv[lane] = E;
            asm volatile("s_waitcnt lgkmcnt(0)" ::: "memory");
            if (lane == 0) flg[F_ST1] = (unsigned)(n + 1);
        }
    }
}
#define ZERO16(x) do { _Pragma("unroll") for (int _i = 0; _i < 16; ++_i) (x)[_i] = 0.f; } while (0)
template <int DB> DI void scan_unit(CArgs& a, LAS unsigned char* sm, int l, int unit, int lane) {
    int s, hh, d; scan_decode(unit, s, hh, d);
    const int T = seq_len(s), mbase = seq_start(s), nchunk = T >> 5;
    unsigned short* yout = (unsigned short*)(a.ws + WS_RBUF) + (size_t)d * PLANE;
    asm volatile("" : "+s"(sm));
    volatile LAS unsigned* flg = (volatile LAS unsigned*)(sm + SlotMap<DB>::O_FLAG);
    f32x16 ST[2][2];
#pragma unroll
    for (int x = 0; x < 2; ++x)
#pragma unroll
        for (int y = 0; y < 2; ++y) ZERO16(ST[x][y]);
#pragma unroll 1
    for (int c = 0; c < nchunk; ++c) {
        const int tok0 = d ? T - 32 * (c + 1) : 32 * c;
        const int b = (DB == 2) ? (c & 1) : 0;
        const LAS unsigned char* nat = sm + O_BUF + b * NC_BUF; const LAS unsigned char* chm = nat + NAT_ALL;
        const LAS float* ecv = (const LAS float*)(sm + SlotMap<DB>::O_SM + b * 512); const LAS float* bon = ecv + 64;
        spin_ge(flg + F_ST0, (unsigned)(c + 1)); spin_ge(flg + F_ST1, (unsigned)(c + 1));
        int lq = lane; asm volatile("" : "+v"(lq)); const int rq = lq & 31, h = lq >> 5;
        const LAS unsigned char* natr = nat + rq * NAT_LD + 16 * h;
#define NATF(arr, ks) (*(const LAS bf16x8*)(natr + (arr) * NAT_ARR + 32 * (ks)))
#define CHMROW(arr, blk) (chm + (arr) * CHM_ARR + (32 * (blk) + rq) * CHM_LD)
#define CHMF(arr, blk, ks) (*(const LAS bf16x8*)(CHMROW(arr, blk) + 32 * (ks) + 16 * h))
        f32x16 Tm, UakT, Wrb, Wrk;
        ZERO16(UakT); ZERO16(Wrb); ZERO16(Wrk);
        {
            f32x16 Nm, NT, TT;
            ZERO16(Nm); ZERO16(NT);
#pragma unroll
            for (int ks = 0; ks < 4; ++ks) { const bf16x8 fb = NATF(0, ks), fa = NATF(2, ks); Nm = MFMA32(fb, fa, Nm); NT = MFMA32(fa, fb, NT); }
#pragma unroll
            for (int i = 0; i < 16; ++i) { const int row = (i & 3) + 8 * (i >> 2) + 4 * h; Nm[i] = row < rq ? Nm[i] : 0.f; NT[i] = rq < row ? NT[i] : 0.f; Tm[i] = Nm[i] + (row == rq ? 1.f : 0.f); TT[i] = NT[i] + (row == rq ? 1.f : 0.f); }
#pragma unroll
            for (int st = 0; st < 4; ++st) {
                const bf16x8 pN0 = packc(Nm, 0), pN1 = packc(Nm, 1), pT0 = packc(NT, 0), pT1 = packc(NT, 1);
                f32x16 N2; ZERO16(N2); N2 = MFMA32(pT0, pN0, N2); N2 = MFMA32(pT1, pN1, N2);
                f32x16 N2T; ZERO16(N2T);
                if (st < 3) { N2T = MFMA32(pN0, pT0, N2T); N2T = MFMA32(pN1, pT1, N2T); }
                { const bf16x8 fb = NATF(0, st), fk = NATF(1, st), fa = NATF(2, st), fr = NATF(3, st);
                  UakT = MFMA32(fa, fk, UakT); Wrb = MFMA32(fb, fr, Wrb); Wrk = MFMA32(fk, fr, Wrk); }
                const bf16x8 pM0 = packc(N2, 0), pM1 = packc(N2, 1), pU0 = packc(TT, 0), pU1 = packc(TT, 1);
                Tm = MFMA32(pU0, pM0, Tm); Tm = MFMA32(pU1, pM1, Tm);
                if (st < 3) { TT = MFMA32(pM0, pU0, TT); TT = MFMA32(pM1, pU1, TT); Nm = N2; NT = N2T; }
            }
        }
        f32x16 Z[2];
        {   f32x16 X, P[2];
            const float bnc = bon[rq];
#pragma unroll
            for (int i = 0; i < 16; ++i) { const int row = (i & 3) + 8 * (i >> 2) + 4 * h; UakT[i] = rq < row ? UakT[i] : 0.f; Wrb[i] = row <= rq ? Wrb[i] : 0.f; Wrk[i] = row <= rq ? Wrk[i] : 0.f; if (row == rq) Wrk[i] += bnc; }
            const bf16x8 pT0 = packc(Tm, 0), pT1 = packc(Tm, 1);
            ZERO16(X); X = MFMA32(packc(UakT, 0), pT0, X); X = MFMA32(packc(UakT, 1), pT1, X);
            const bf16x8 pX0 = packc(X, 0), pX1 = packc(X, 1);
#pragma unroll
            for (int b2 = 0; b2 < 2; ++b2) { ZERO16(P[b2]); ZERO16(Z[b2]);
                P[b2] = MFMA32(ld_perm(CHMROW(0, b2), 0, h), pT0, P[b2]); P[b2] = MFMA32(ld_perm(CHMROW(0, b2), 1, h), pT1, P[b2]);
                Z[b2] = MFMA32(pX0, ld_perm(CHMROW(1, b2), 0, h), Z[b2]); Z[b2] = MFMA32(pX1, ld_perm(CHMROW(1, b2), 1, h), Z[b2]); }
#pragma unroll
            for (int jb = 0; jb < 2; ++jb) { const bf16x8 p0 = packc(P[jb], 0), p1 = packc(P[jb], 1);
#pragma unroll
                for (int ib = 0; ib < 2; ++ib) { Z[ib] = MFMA32(p0, packc(ST[jb][ib], 0), Z[ib]); Z[ib] = MFMA32(p1, packc(ST[jb][ib], 1), Z[ib]); } }
        }
        {   f32x16 Y[2];
            const bf16x8 pK0 = packc(Wrk, 0), pK1 = packc(Wrk, 1), pW0 = packc(Wrb, 0), pW1 = packc(Wrb, 1);
            const LAS unsigned char* rrow = nat + 3 * NAT_ARR + rq * NAT_LD;
#pragma unroll
            for (int ib = 0; ib < 2; ++ib) { ZERO16(Y[ib]);
                Y[ib] = MFMA32(pK0, ld_perm(CHMROW(1, ib), 0, h), Y[ib]); Y[ib] = MFMA32(pK1, ld_perm(CHMROW(1, ib), 1, h), Y[ib]);
                Y[ib] = MFMA32(pW0, packc(Z[ib], 0), Y[ib]); Y[ib] = MFMA32(pW1, packc(Z[ib], 1), Y[ib]);
#pragma unroll
                for (int jb = 0; jb < 2; ++jb) { Y[ib] = MFMA32(ld_perm(rrow + 64 * jb, 0, h), packc(ST[jb][ib], 0), Y[ib]); Y[ib] = MFMA32(ld_perm(rrow + 64 * jb, 1, h), packc(ST[jb][ib], 1), Y[ib]); } }
#pragma unroll
            for (int ib = 0; ib < 2; ++ib)
#pragma unroll
                for (int i = 0; i < 16; ++i) { const int tau = (i & 3) + 8 * (i >> 2) + 4 * h; const int tok = tok0 + (d ? 31 - tau : tau);
                    yout[(size_t)(mbase + tok) * 1024 + hh * 64 + 32 * ib + rq] = (unsigned short)pkbf(Y[ib][i], 0.f); }
        }
        {
#pragma unroll
            for (int ib = 0; ib < 2; ++ib) { const bf16x8 pZ0 = packc(Z[ib], 0), pZ1 = packc(Z[ib], 1);
#pragma unroll
                for (int jc = 0; jc < 2; ++jc) {
                    ST[jc][ib] = MFMA32(ld_perm(CHMROW(2, jc), 0, h), pZ0, ST[jc][ib]); ST[jc][ib] = MFMA32(ld_perm(CHMROW(2, jc), 1, h), pZ1, ST[jc][ib]);
                    ST[jc][ib] = MFMA32(CHMF(3, jc, 0), CHMF(1, ib, 0), ST[jc][ib]); ST[jc][ib] = MFMA32(CHMF(3, jc, 1), CHMF(1, ib, 1), ST[jc][ib]); } }
#pragma unroll
            for (int jc = 0; jc < 2; ++jc)
#pragma unroll
                for (int g4 = 0; g4 < 4; ++g4) { const f32x4 e = *(const LAS f32x4*)(ecv + 32 * jc + 8 * g4 + 4 * h);
#pragma unroll
                    for (int ib = 0; ib < 2; ++ib) { ST[jc][ib][4 * g4 + 0] *= e.x; ST[jc][ib][4 * g4 + 1] *= e.y; ST[jc][ib][4 * g4 + 2] *= e.z; ST[jc][ib][4 * g4 + 3] *= e.w; } }
        }
#undef NATF
#undef CHMROW
#undef CHMF
        asm volatile("s_waitcnt lgkmcnt(0)" ::: "memory");
        if (lane == 0) flg[F_CONS] = (unsigned)(c + 1);
    }
}
DI void phase_scan(CArgs& a, LAS unsigned char* lds, int l, int lane, int wave, int G) {
    LAS unsigned char* sm1 = lds + SLOT0;
    if (wave == 0 && lane < 16) ((LAS unsigned*)(lds + SlotMap<2>::O_FLAG))[lane] = 0u;
    if (wave == 1 && lane < 16) ((LAS unsigned*)(sm1 + SlotMap<1>::O_FLAG))[lane] = 0u;
    __syncthreads();
    const bool has1 = blockIdx.x < 128;
    const int nbg = G + (G - 128) * 3;
    if (wave == 0) scan_unit<2>(a, lds, l, blockIdx.x, lane);
    else if (wave == 2) scan_helper<2>(a, lds, l, blockIdx.x, lane, 0);
    else if (wave == 3) scan_helper<2>(a, lds, l, blockIdx.x, lane, 1);
    else if (wave == 4) { }
    else if (wave == 5) background_weights(a, l, (LAS float*)(lds + SLOT0 + SLOT1), blockIdx.x, nbg, lane);
    else if (has1) { if (wave == 1) scan_unit<1>(a, sm1, l, 256 + blockIdx.x, lane); else if (wave == 6) scan_helper<1>(a, sm1, l, 256 + blockIdx.x, lane, 0); else scan_helper<1>(a, sm1, l, 256 + blockIdx.x, lane, 1); }
    else { const int q = wave == 1 ? 0 : wave == 6 ? 1 : 2; background_weights(a, l, (LAS float*)(sm1 + q * 4224), G + (blockIdx.x - 128) * 3 + q, nbg, lane); }
}


DI void phase_post(CArgs& a, int l, int lane, int wave, int G) {
    const unsigned short* y0 = (const unsigned short*)(a.ws + WS_RBUF); const unsigned short* y1 = y0 + PLANE;
    unsigned short* mx = (unsigned short*)(a.ws + WS_MIXIN);
    const unsigned short* gbuf = (const unsigned short*)(a.ws + WS_G) + (size_t)(lane >> 3) * TOK * 32 + 4 * (lane & 7);
    const float* ssq = (const float*)(a.ws + WS_SSQ);
    f32x4 lnw[4], lnb[4];
#pragma unroll
    for (int j = 0; j < 4; ++j) { const int c = 4 * (lane + 64 * j); lnw[j] = *(const f32x4*)(a.in[I_LNW] + l * 1024 + c); lnb[j] = *(const f32x4*)(a.in[I_LNB] + l * 1024 + c); }
    u32x2 ny0[4], ny1[4]; f32x4 ns0, ns1; u32x2 ng[4];
#define POST_LOAD(mm_) do { _Pragma("unroll") for (int j = 0; j < 4; ++j) { ny0[j] = __builtin_nontemporal_load((const u32x2*)(y0 + (size_t)(mm_) * 1024) + lane + 64 * j); ny1[j] = __builtin_nontemporal_load((const u32x2*)(y1 + (size_t)(mm_) * 1024) + lane + 64 * j); \
            ng[j] = __builtin_nontemporal_load((const u32x2*)(gbuf + ((size_t)8 * j * TOK + (mm_)) * 32)); } \
            ns0 = *(const f32x4*)(ssq + (size_t)(mm_) * 8); ns1 = *(const f32x4*)(ssq + (size_t)(mm_) * 8 + 4); } while (0)
    int m = blockIdx.x * 8 + wave;
    if (m < TOK) POST_LOAD(m);
#pragma unroll 1
    for (; m < TOK; m += G * 8) {
        f32x4 y[4]; u32x2 g[4]; const f32x4 s0 = ns0, s1 = ns1;
#pragma unroll
        for (int j = 0; j < 4; ++j) { y[j] = (f32x4){bflo(ny0[j].x) + bflo(ny1[j].x), bfhi(ny0[j].x) + bfhi(ny1[j].x), bflo(ny0[j].y) + bflo(ny1[j].y), bfhi(ny0[j].y) + bfhi(ny1[j].y)}; g[j] = ng[j]; }
        if (m + G * 8 < TOK) POST_LOAD(m + G * 8);
        const float irs = __builtin_sqrtf(((s0.x + s0.y) + (s0.z + s0.w) + (s1.x + s1.y) + (s1.z + s1.w)) * (1.0f / 1024.0f) + NORM_EPS);
#pragma unroll
        for (int j = 0; j < 4; ++j) {
            float sum = (y[j].x + y[j].y) + (y[j].z + y[j].w);
            sum = DPP_ROR_ADD(sum, 8); sum = DPP_ROR_ADD(sum, 4); sum = DPP_ROR_ADD(sum, 2); sum = DPP_ROR_ADD(sum, 1);
            const float mean = sum * (1.0f / 64.0f);
            const f32x4 dv = y[j] - mean;
            float sq = (dv.x * dv.x + dv.y * dv.y) + (dv.z * dv.z + dv.w * dv.w);
            sq = DPP_ROR_ADD(sq, 8); sq = DPP_ROR_ADD(sq, 4); sq = DPP_ROR_ADD(sq, 2); sq = DPP_ROR_ADD(sq, 1);
            const float rstd = __builtin_amdgcn_rsqf(sq * (1.0f / 64.0f) + GN_EPS);
            const f32x4 o = (dv * rstd * lnw[j] + lnb[j]) * ((f32x4){hlo(g[j].x), hhi(g[j].x), hlo(g[j].y), hhi(g[j].y)} * irs);
            u32x2 w; w.x = pk2(o.x, o.y); w.y = pk2(o.z, o.w);
            ((u32x2*)(mx + (size_t)m * D + 1024))[lane + 64 * j] = w; }
    }
#undef POST_LOAD
}
constexpr int NPHASE = 2 + 10 * DEPTH;
__global__ void __launch_bounds__(512, 2) hymba_fwd(Args args) {
    extern __shared__ __attribute__((aligned(16))) unsigned char lds_raw[];
    LAS unsigned char* lds = (LAS unsigned char*)lds_raw;
    const int G = gridDim.x;
    const int wave_sgpr = __builtin_amdgcn_readfirstlane(threadIdx.x >> 6);
    if (threadIdx.x < 64) ((LAS unsigned*)(lds + L_MISC))[threadIdx.x] = 0u;
    __syncthreads();
    const int lo = args.ph_lo, hi = args.ph_hi;
    XcdBarrier bar; bar.bar = (unsigned*)(args.ws + WS_CTL) + CW_BAR; bar.x = 0; bar.st = nullptr;
    if (hi - lo > 1) bar = xcd_barrier_post((unsigned*)(args.ws + WS_CTL) + CW_BAR, (volatile LAS unsigned*)(lds + L_MISC));
#define PH(k) (lo <= (k) && (k) < hi)
#define LANE_IDS CArgs* ap_ = (CArgs*)__builtin_amdgcn_kernarg_segment_ptr(); asm volatile("" : "+s"(ap_)); CArgs& A = *ap_; unsigned z_; asm volatile("v_mov_b32 %0, 0" : "=v"(z_)); const int tid = wave_sgpr * 64 + (int)__builtin_amdgcn_mbcnt_hi(~0u, __builtin_amdgcn_mbcnt_lo(~0u, z_)); const int lane = tid & 63, wave = __builtin_amdgcn_readfirstlane(tid >> 6); (void)lane; (void)wave
#define SEAM(k) do { if (PH(k) && PH((k) + 1)) { xcd_barrier(bar); if (MK_PROBE_REP == 100) xcd_barrier(bar); } } while (0)
#ifndef MK_PROBE_REP
#define MK_PROBE_REP -1
#endif
#define NREP(k) ((MK_PROBE_REP == (k)) ? 2 : 1)
    if (PH(0)) { LANE_IDS; phase_prologue(A, lds, tid, lane, wave, G); }
#if MK_PROBE_REP == 101
    xcd_barrier(bar); if (PH(0)) { LANE_IDS; phase_prologue(A, lds, tid, lane, wave, G); }
#endif
    SEAM(0);
#if MK_PROBE_REP == 103
    if (PH(1)) { LANE_IDS; const f32x4* src_ = (const f32x4*)A.in[I_XP]; f32x4* dst_ = (f32x4*)(A.ws + WS_HID);
        for (int m = blockIdx.x * 8 + wave; m < 32768; m += G * 8) { f32x4 v_[8];
#pragma unroll
            for (int j = 0; j < 8; ++j) v_[j] = __builtin_nontemporal_load(src_ + (size_t)m * 512 + lane + 64 * j);
#pragma unroll
            for (int j = 0; j < 8; ++j) __builtin_nontemporal_store(v_[j], dst_ + (size_t)m * 512 + lane + 64 * j); } }
    if (PH(1)) xcd_barrier(bar);
#endif
    if (PH(1)) { LANE_IDS; phase_resnorm(A, lds, 0, 0, tid, lane, wave, G); }
#if MK_PROBE_REP == 102
    xcd_barrier(bar); if (PH(1)) { LANE_IDS; phase_resnorm(A, lds, 0, 0, tid, lane, wave, G); }
#endif
    SEAM(1);
#pragma unroll 1
    for (int l = 0; l < DEPTH; ++l) {
        const int b = 2 + 10 * l;
        if (PH(b + 0)) { LANE_IDS;
            pg8::Gemm g{(const pg8::bf16_t*)(A.ws + WS_HB), (const pg8::bf16_t*)(A.ws + WS_WIN) + (size_t)(l & 1) * NIN * D, TOK, l == 0 ? NIN - 256 : NIN, D}; pg8::StaticOrder S; S.init(TOK, l == 0 ? NIN - 256 : NIN, G, (int)blockIdx.x);
            pg8::EpiOut<0> E{(pg8::bf16_t*)(A.ws + WS_QKV), NQKV, (pg8::bf16_t*)(A.ws + WS_LORA), NLB, NQKV / 256, (pg8::bf16_t*)(A.ws + WS_RBUF), 12, TOK};
            pg8::gemm_phase<pg8::EpiOut<0>, pg8::StaticOrder, true, true>(lds + L_RING, g, S, E, tid);
        }
#if MK_PROBE_REP == 0
        xcd_barrier(bar);
        if (PH(b + 0)) { LANE_IDS;
            pg8::Gemm g{(const pg8::bf16_t*)(A.ws + WS_HB), (const pg8::bf16_t*)(A.ws + WS_WIN) + (size_t)(l & 1) * NIN * D, TOK, l == 0 ? NIN - 256 : NIN, D}; pg8::StaticOrder S; S.init(TOK, l == 0 ? NIN - 256 : NIN, G, (int)blockIdx.x);
            pg8::EpiOut<0> E{(pg8::bf16_t*)(A.ws + WS_QKV), NQKV, (pg8::bf16_t*)(A.ws + WS_LORA), NLB, NQKV / 256, (pg8::bf16_t*)(A.ws + WS_RBUF), 12, TOK};
            pg8::gemm_phase<pg8::EpiOut<0>, pg8::StaticOrder, true, true>(lds + L_RING, g, S, E, tid);
        }
#endif
        SEAM(b + 0);
        if (PH(b + 1)) { LANE_IDS; phase_attention(A, lds, l, tid, lane, wave, G); }
#if MK_PROBE_REP == 1
        xcd_barrier(bar); if (PH(b + 1)) { LANE_IDS; phase_attention(A, lds, l, tid, lane, wave, G); }
#endif
        SEAM(b + 1);
        if (PH(b + 2)) { LANE_IDS; phase_prep(A, lds, l, tid, lane, wave, G); }
#if MK_PROBE_REP == 2
        xcd_barrier(bar); if (PH(b + 2)) { LANE_IDS; phase_prep(A, lds, l, tid, lane, wave, G); }
#endif
        SEAM(b + 2);
        if (PH(b + 3)) { LANE_IDS; phase_scan(A, lds, l, lane, wave, G); }
#if MK_PROBE_REP == 3
        xcd_barrier(bar); if (PH(b + 3)) { LANE_IDS; phase_scan(A, lds, l, lane, wave, G); }
#endif
        SEAM(b + 3);
        if (PH(b + 4)) { LANE_IDS; phase_post(A, l, lane, wave, G); }
        SEAM(b + 4);
        if (PH(b + 5)) { LANE_IDS;
            pg8::Gemm g{(const pg8::bf16_t*)(A.ws + WS_MIXIN), (const pg8::bf16_t*)(A.ws + WS_WOUT) + (size_t)(l & 1) * D * D, TOK, D, D}; pg8::StaticOrder S; S.init(TOK, D, G, (int)blockIdx.x);
            pg8::EpiOut<0> E{(pg8::bf16_t*)(A.ws + WS_RBUF), D, nullptr, 0, 1 << 30, nullptr, 0, 0};
            pg8::gemm_phase<pg8::EpiOut<0>, pg8::StaticOrder, true, true>(lds + L_RING, g, S, E, tid);
        }
#if MK_PROBE_REP == 5
        xcd_barrier(bar);
        if (PH(b + 5)) { LANE_IDS;
            pg8::Gemm g{(const pg8::bf16_t*)(A.ws + WS_MIXIN), (const pg8::bf16_t*)(A.ws + WS_WOUT) + (size_t)(l & 1) * D * D, TOK, D, D}; pg8::StaticOrder S; S.init(TOK, D, G, (int)blockIdx.x);
            pg8::EpiOut<0> E{(pg8::bf16_t*)(A.ws + WS_RBUF), D, nullptr, 0, 1 << 30, nullptr, 0, 0};
            pg8::gemm_phase<pg8::EpiOut<0>, pg8::StaticOrder, true, true>(lds + L_RING, g, S, E, tid);
        }
#endif
        SEAM(b + 5);
        if (PH(b + 6)) { LANE_IDS; phase_resnorm(A, lds, l, 1, tid, lane, wave, G); }
        SEAM(b + 6);
        if (PH(b + 7)) { LANE_IDS;
            pg8::Gemm g{(const pg8::bf16_t*)(A.ws + WS_HB), (const pg8::bf16_t*)(A.ws + WS_WF1), TOK, DFF, D}; pg8::StaticOrder S; S.init(TOK, DFF, G, (int)blockIdx.x);
            pg8::EpiOut<1> E{(pg8::bf16_t*)(A.ws + WS_HID), DFF, nullptr, 0, 1 << 30, nullptr, 0, 0};
            pg8::gemm_phase<pg8::EpiOut<1>, pg8::StaticOrder, true, true>(lds + L_RING, g, S, E, tid);
        }
#if MK_PROBE_REP == 7
        xcd_barrier(bar);
        if (PH(b + 7)) { LANE_IDS;
            pg8::Gemm g{(const pg8::bf16_t*)(A.ws + WS_HB), (const pg8::bf16_t*)(A.ws + WS_WF1), TOK, DFF, D}; pg8::StaticOrder S; S.init(TOK, DFF, G, (int)blockIdx.x);
            pg8::EpiOut<1> E{(pg8::bf16_t*)(A.ws + WS_HID), DFF, nullptr, 0, 1 << 30, nullptr, 0, 0};
            pg8::gemm_phase<pg8::EpiOut<1>, pg8::StaticOrder, true, true>(lds + L_RING, g, S, E, tid);
        }
#endif
        SEAM(b + 7);
        if (PH(b + 8)) { LANE_IDS;
            pg8::Gemm g{(const pg8::bf16_t*)(A.ws + WS_HID), (const pg8::bf16_t*)(A.ws + WS_WF2), TOK, D, DFF}; pg8::StaticOrder S; S.init(TOK, D, G, (int)blockIdx.x);
            pg8::EpiOut<0> E{(pg8::bf16_t*)(A.ws + WS_EX), D, nullptr, 0, 1 << 30, nullptr, 0, 0};
            pg8::gemm_phase<pg8::EpiOut<0>, pg8::StaticOrder, true, true>(lds + L_RING, g, S, E, tid);
        }
#if MK_PROBE_REP == 8
        xcd_barrier(bar);
        if (PH(b + 8)) { LANE_IDS;
            pg8::Gemm g{(const pg8::bf16_t*)(A.ws + WS_HID), (const pg8::bf16_t*)(A.ws + WS_WF2), TOK, D, DFF}; pg8::StaticOrder S; S.init(TOK, D, G, (int)blockIdx.x);
            pg8::EpiOut<0> E{(pg8::bf16_t*)(A.ws + WS_EX), D, nullptr, 0, 1 << 30, nullptr, 0, 0};
            pg8::gemm_phase<pg8::EpiOut<0>, pg8::StaticOrder, true, true>(lds + L_RING, g, S, E, tid);
        }
#endif
        SEAM(b + 8);
        if (PH(b + 9)) { LANE_IDS; phase_resnorm(A, lds, l, 2, tid, lane, wave, G); }
        SEAM(b + 9);
    }
#undef PH
#undef SEAM
}

extern "C" void kernel_launch(void* const* d_in, const int* in_sizes, int n_in, void* d_out, int out_size, void* d_ws, size_t ws_size, hipStream_t stream) {
    static int grid = 0;
    if (grid == 0) {
        if (n_in != 35 || out_size != TOK * D || ws_size < WS_END) { fprintf(stderr, "kernel_launch: unexpected problem (n_in %d, out %d, ws %zu); nothing launched\n", n_in, out_size, ws_size); grid = -1; return; }
        int dev = 0, cus = 0, per_cu = 0;
        if (hipGetDevice(&dev) != hipSuccess || hipDeviceGetAttribute(&cus, hipDeviceAttributeMultiprocessorCount, dev) != hipSuccess) { grid = -1; return; }
        if (hipFuncSetAttribute((const void*)hymba_fwd, hipFuncAttributeMaxDynamicSharedMemorySize, LDS_BYTES) != hipSuccess) { fprintf(stderr, "kernel_launch: hipFuncSetAttribute failed\n"); grid = -1; return; }
        if (hipOccupancyMaxActiveBlocksPerMultiprocessor(&per_cu, (const void*)hymba_fwd, 512, LDS_BYTES) != hipSuccess || per_cu < 1) { fprintf(stderr, "kernel_launch: occupancy query says %d blocks per CU\n", per_cu); (void)hipGetLastError(); grid = -1; return; }
        grid = cus;
    }
    if (grid < 0) return;
    (void)hipMemsetAsync((char*)d_ws + WS_CTL, 0, CTL_ZERO_BYTES, stream);
    Args a{};
    for (int i = 0; i < 35; ++i) a.in[i] = (const float*)d_in[i];
    a.out = (float*)d_out; a.ws = (unsigned char*)d_ws;
#if MK_LAUNCH_PER_PHASE
    for (int p = 0; p < NPHASE; ++p) { a.ph_lo = p; a.ph_hi = p + 1; hipLaunchKernelGGL(hymba_fwd, dim3(grid), dim3(512), LDS_BYTES, stream, a); }
#else
    a.ph_lo = 0; a.ph_hi = NPHASE; hipLaunchKernelGGL(hymba_fwd, dim3(grid), dim3(512), LDS_BYTES, stream, a);
#endif
    const hipError_t le = hipPeekAtLastError();
    if (le != hipSuccess) fprintf(stderr, "kernel_launch: launch failed: %s\n", hipGetErrorName(le));
}
```
